# Optimizing an MI355X kernel written in HIP

```python
import math
import jax, jax.numpy as jnp
from jax import lax
import numpy as np

D_MODEL = 1024
BATCH = 16
SEQ = 256
DEPTH = 4
DEC_BATCH = 8
DEC_SEQ = 1024
PAST_LEN = 512

GRID_W = 64
N_MIXERS = 4
Q_BLOCK = 128
RMS_EPS = 1e-6
ROPE_THETA = 10000.0
NEG_INF = -1e30
D_FF = 2816
FFN_RES = 0.5
N_MOD = 9
HEAD_DIM = 64
A_HEADS = 16
A_KV_HEADS = 4
A_WINDOW = 128
B_HEADS = 16
B_KV_HEADS = 4
C_HEADS = 16
C_Q_RANK = 384
C_KV_RANK = 256
C_NOPE = 64
C_ROPE = 32
C_V = 64
C_QK = C_NOPE + C_ROPE
D_HEADS = 16
NA_ROWS = 8
NA_COLS = 16
NA_QCOLS = 16
NA_KCOLS = 2 * NA_COLS
N_A = (DEPTH + 3) // 4
N_B = (DEPTH + 2) // 4
N_C = (DEPTH + 1) // 4
N_D = DEPTH // 4

kernel_name = 'hybrid_diffusion_interleaved_step'


def rms_norm(x, g):
    xf = x.astype(jnp.float32)
    y = xf * lax.rsqrt(jnp.mean(xf * xf, axis=-1, keepdims=True) + RMS_EPS)
    return (y * g.astype(jnp.float32)).astype(x.dtype)


def modulate(x, g, shift, scale):
    return rms_norm(x, g) * (1 + scale) + shift


def modulation(cond, w, b):
    return jnp.split(jax.nn.silu(cond) @ w + b, N_MOD, axis=-1)


def half_ffn(x, shift, scale, gate, g, w_gu, w_down):
    h = modulate(x, g, shift, scale)
    a, u = jnp.split(h @ w_gu, 2, axis=-1)
    return x + FFN_RES * gate * ((jax.nn.silu(a) * u) @ w_down)


def grid_angles(n, rot_dim):
    pos = jnp.arange(n, dtype=jnp.int32)
    row = (pos // GRID_W).astype(jnp.float32)
    col = (pos % GRID_W).astype(jnp.float32)
    n_ax = rot_dim // 4
    inv = ROPE_THETA ** (-jnp.arange(n_ax, dtype=jnp.float32) / n_ax)
    return jnp.concatenate([row[:, None] * inv, col[:, None] * inv], axis=-1)


def apply_rope(x, ang):
    shape = x.shape
    xr = x.astype(jnp.float32).reshape(shape[:-1] + (shape[-1] // 2, 2))
    ang = ang.reshape(ang.shape[:1] + (1,) * (x.ndim - 3) + ang.shape[1:])
    cos, sin = jnp.cos(ang), jnp.sin(ang)
    x0, x1 = xr[..., 0], xr[..., 1]
    out = jnp.stack([x0 * cos - x1 * sin, x0 * sin + x1 * cos], axis=-1)
    return out.reshape(shape).astype(x.dtype)


def block_attention(q, k, v, sink=None):
    b, n, hkv, g, dk = q.shape
    nb = n // Q_BLOCK
    scale = dk ** -0.5
    n_keys = k.shape[1]
    qb = jnp.moveaxis(q.reshape(b, nb, Q_BLOCK, hkv, g, dk), 1, 0)

    def one_block(qi):
        s = jnp.einsum('bqhgd,bkhd->bhgqk', qi, k).astype(jnp.float32) * scale
        if sink is not None:
            s_sink = jnp.broadcast_to(sink.astype(jnp.float32).reshape(1, hkv, g, 1, 1), s.shape[:-1] + (1,))
            s = jnp.concatenate([s, s_sink], axis=-1)
        p = jax.nn.softmax(s, axis=-1)[..., :n_keys].astype(v.dtype)
        return jnp.einsum('bhgqk,bkhd->bqhgd', p, v)

    out = lax.map(one_block, qb)
    return jnp.moveaxis(out, 0, 1).reshape(b, n, hkv, g, v.shape[-1])


def window_attention(q, k, v, kc, vc, sink):
    b, n, hkv, g, d = q.shape
    nb = n // Q_BLOCK
    scale = d ** -0.5
    pad = ((0, 0), (Q_BLOCK, Q_BLOCK), (0, 0), (0, 0))
    kp = jnp.pad(k, pad).reshape(b, nb + 2, Q_BLOCK, hkv, d)
    vp = jnp.pad(v, pad).reshape(b, nb + 2, Q_BLOCK, hkv, d)
    kw = jnp.moveaxis(jnp.concatenate([kp[:, :-2], kp[:, 1:-1], kp[:, 2:]], axis=2), 1, 0)
    vw = jnp.moveaxis(jnp.concatenate([vp[:, :-2], vp[:, 1:-1], vp[:, 2:]], axis=2), 1, 0)
    qb = jnp.moveaxis(q.reshape(b, nb, Q_BLOCK, hkv, g, d), 1, 0)
    blk = jnp.arange(nb)
    qpos = blk[:, None] * Q_BLOCK + jnp.arange(Q_BLOCK)[None, :]
    kpos = (blk[:, None] - 1) * Q_BLOCK + jnp.arange(3 * Q_BLOCK)[None, :]
    valid = ((kpos[:, None, :] >= 0) & (kpos[:, None, :] < n)
             & (jnp.abs(qpos[:, :, None] - kpos[:, None, :]) <= A_WINDOW))
    sink_f = sink.astype(jnp.float32).reshape(1, hkv, g, 1, 1)
    n_win = 3 * Q_BLOCK
    n_ctx = kc.shape[1]

    def one_block(args):
        qi, ki, vi, mi = args
        s_w = jnp.einsum('bqhgd,bkhd->bhgqk', qi, ki).astype(jnp.float32) * scale
        s_w = jnp.where(mi[None, None, None], s_w, NEG_INF)
        s_c = jnp.einsum('bqhgd,bkhd->bhgqk', qi, kc).astype(jnp.float32) * scale
        s_s = jnp.broadcast_to(sink_f, s_w.shape[:-1] + (1,))
        p = jax.nn.softmax(jnp.concatenate([s_w, s_c, s_s], axis=-1), axis=-1).astype(v.dtype)
        return (jnp.einsum('bhgqk,bkhd->bqhgd', p[..., :n_win], vi)
                + jnp.einsum('bhgqk,bkhd->bqhgd', p[..., n_win:n_win + n_ctx], vc))

    out = lax.map(one_block, (qb, kw, vw, valid))
    return jnp.moveaxis(out, 0, 1).reshape(b, n, hkv, g, d)


def neighbourhood_attention(q, k, v, kc, vc, rpb):
    b, n, h, d = q.shape
    rows = n // GRID_W
    wh = min(NA_ROWS, rows)
    ncb = GRID_W // NA_QCOLS
    nqb = rows * ncb
    nk = wh * NA_KCOLS
    blk = jnp.arange(nqb)
    r = blk // ncb
    c0 = (blk % ncb) * NA_QCOLS
    rs = jnp.clip(r - wh // 2, 0, rows - wh)
    cb = jnp.clip(c0 - NA_COLS // 2, 0, GRID_W - NA_KCOLS)
    koff = jnp.arange(nk)
    kr = rs[:, None] + (koff // NA_KCOLS)[None, :]
    kcol = cb[:, None] + (koff % NA_KCOLS)[None, :]
    kidx = kr * GRID_W + kcol
    qcol = c0[:, None] + jnp.arange(NA_QCOLS)[None, :]
    cs = jnp.clip(qcol - NA_COLS // 2, 0, GRID_W - NA_COLS)
    valid = (kcol[:, None, :] >= cs[:, :, None]) & (kcol[:, None, :] < cs[:, :, None] + NA_COLS)
    ri = jnp.broadcast_to(jnp.clip(kr - r[:, None] + NA_ROWS - 1, 0, 2 * NA_ROWS - 2)[:, None, :], valid.shape)
    ci = jnp.clip(kcol[:, None, :] - qcol[:, :, None] + NA_COLS - 1, 0, 2 * NA_COLS - 2)
    scale = d ** -0.5
    qb = jnp.moveaxis(q.reshape(b, nqb, NA_QCOLS, h, d), 1, 0)
    rpb_f = rpb.astype(jnp.float32)

    def one_block(args):
        qi, idx, m, ri_i, ci_i = args
        kb = jnp.take(k, idx, axis=1)
        vb = jnp.take(v, idx, axis=1)
        s_n = jnp.einsum('bqhd,bkhd->bhqk', qi, kb).astype(jnp.float32) * scale + rpb_f[:, ri_i, ci_i][None]
        s_n = jnp.where(m[None, None], s_n, NEG_INF)
        s_c = jnp.einsum('bqhd,bkhd->bhqk', qi, kc).astype(jnp.float32) * scale
        p = jax.nn.softmax(jnp.concatenate([s_n, s_c], axis=-1), axis=-1).astype(v.dtype)
        return (jnp.einsum('bhqk,bkhd->bqhd', p[..., :nk], vb)
                + jnp.einsum('bhqk,bkhd->bqhd', p[..., nk:], vc))

    out = lax.map(one_block, (qb, kidx, valid, ri, ci))
    return jnp.moveaxis(out, 0, 1).reshape(b, n, h, d)


def gqa_project(h, w_qkv, q_norm, k_norm, n_heads, n_kv):
    b, n, _ = h.shape
    q, k, v = jnp.split(h @ w_qkv, [n_heads * HEAD_DIM, (n_heads + n_kv) * HEAD_DIM], axis=-1)
    q = rms_norm(q.reshape(b, n, n_heads, HEAD_DIM), q_norm)
    k = rms_norm(k.reshape(b, n, n_kv, HEAD_DIM), k_norm)
    return q, k, v.reshape(b, n, n_kv, HEAD_DIM)


def group_q(q, n_kv):
    b, n, hq, d = q.shape
    return q.reshape(b, n, n_kv, hq // n_kv, d)


def merge_heads(o, w_o):
    b, n = o.shape[:2]
    return o.reshape(b, n, -1) @ w_o


def mla_compress(h, w_down, q_lnorm, kv_lnorm):
    cq, ckv, kr = jnp.split(h @ w_down, [C_Q_RANK, C_Q_RANK + C_KV_RANK], axis=-1)
    return rms_norm(cq, q_lnorm), rms_norm(ckv, kv_lnorm), kr


def rope_tail(x, ang):
    return jnp.concatenate([x[..., :C_NOPE], apply_rope(x[..., C_NOPE:], ang)], axis=-1)


def mla_queries(cq, w_uq, q_norm, ang):
    b, n, _ = cq.shape
    q = rms_norm((cq @ w_uq).reshape(b, n, C_HEADS, C_QK), q_norm)
    if ang is not None:
        q = rope_tail(q, ang)
    return q[:, :, :, None, :]


def mla_keys_values(ckv, kr, w_ukv, k_norm, ang):
    b, n, _ = ckv.shape
    k_nope, v = jnp.split((ckv @ w_ukv).reshape(b, n, C_HEADS, C_NOPE + C_V), [C_NOPE], axis=-1)
    k = jnp.concatenate([k_nope, jnp.broadcast_to(kr[:, :, None, :], (b, n, C_HEADS, C_ROPE))], axis=-1)
    k = rms_norm(k, k_norm)
    if ang is not None:
        k = rope_tail(k, ang)
    return k, v


def setup_inputs(seed: int = 0) -> dict:
    key = jax.random.key(seed)
    ks = iter(jax.random.split(key, 64))

    def nrm(shape, s=1.0):
        return s * jax.random.normal(next(ks), shape, jnp.float32)

    def lin(shape):
        return nrm(shape, shape[-2] ** -0.5)

    def gain(shape):
        return 1.0 + nrm(shape, 0.05)

    D = D_MODEL
    qkv_a = (A_HEADS + 2 * A_KV_HEADS) * HEAD_DIM
    qkv_b = (B_HEADS + 2 * B_KV_HEADS) * HEAD_DIM
    qkv_d = 3 * D_HEADS * HEAD_DIM
    return {
        'x_prompt': nrm((BATCH, SEQ, D)),
        'x_sample': nrm((DEC_BATCH, DEC_SEQ, D)),
        'cache_a_k': nrm((DEC_BATCH, N_A, PAST_LEN, A_KV_HEADS, HEAD_DIM)),
        'cache_a_v': nrm((DEC_BATCH, N_A, PAST_LEN, A_KV_HEADS, HEAD_DIM)),
        'cache_b_k': nrm((DEC_BATCH, N_B, PAST_LEN, B_KV_HEADS, HEAD_DIM)),
        'cache_b_v': nrm((DEC_BATCH, N_B, PAST_LEN, B_KV_HEADS, HEAD_DIM)),
        'cache_c_kv': nrm((DEC_BATCH, N_C, PAST_LEN, C_KV_RANK)),
        'cache_c_krope': nrm((DEC_BATCH, N_C, PAST_LEN, C_ROPE)),
        'cache_d_k': nrm((DEC_BATCH, N_D, PAST_LEN, D_HEADS, HEAD_DIM)),
        'cache_d_v': nrm((DEC_BATCH, N_D, PAST_LEN, D_HEADS, HEAD_DIM)),
        'c': nrm((DEC_BATCH, D)),
        'c_ctx': nrm((D,)),
        'mod_w': nrm((DEPTH, D, N_MOD * D), 0.5 * D ** -0.5),
        'mod_b': nrm((DEPTH, N_MOD * D), 0.02),
        'norm_ff1': gain((DEPTH, D)),
        'norm_mix': gain((DEPTH, D)),
        'norm_ff2': gain((DEPTH, D)),
        'ff1_w_gu': lin((DEPTH, D, 2 * D_FF)),
        'ff1_w_down': lin((DEPTH, D_FF, D)),
        'ff2_w_gu': lin((DEPTH, D, 2 * D_FF)),
        'ff2_w_down': lin((DEPTH, D_FF, D)),
        'a_w_qkv': lin((N_A, D, qkv_a)),
        'a_q_norm': gain((N_A, HEAD_DIM)),
        'a_k_norm': gain((N_A, HEAD_DIM)),
        'a_sink': nrm((N_A, A_HEADS)),
        'a_w_o': lin((N_A, A_HEADS * HEAD_DIM, D)),
        'b_w_qkv': lin((N_B, D, qkv_b)),
        'b_q_norm': gain((N_B, HEAD_DIM)),
        'b_k_norm': gain((N_B, HEAD_DIM)),
        'b_w_o': lin((N_B, B_HEADS * HEAD_DIM, D)),
        'c_w_down': lin((N_C, D, C_Q_RANK + C_KV_RANK + C_ROPE)),
        'c_q_lnorm': gain((N_C, C_Q_RANK)),
        'c_kv_lnorm': gain((N_C, C_KV_RANK)),
        'c_w_uq': lin((N_C, C_Q_RANK, C_HEADS * C_QK)),
        'c_w_ukv': lin((N_C, C_KV_RANK, C_HEADS * (C_NOPE + C_V))),
        'c_q_norm': gain((N_C, C_QK)),
        'c_k_norm': gain((N_C, C_QK)),
        'c_w_o': lin((N_C, C_HEADS * C_V, D)),
        'd_w_qkv': lin((N_D, D, qkv_d)),
        'd_q_norm': gain((N_D, HEAD_DIM)),
        'd_k_norm': gain((N_D, HEAD_DIM)),
        'd_rpb': nrm((N_D, D_HEADS, 2 * NA_ROWS - 1, 2 * NA_COLS - 1), 0.5),
        'd_w_o': lin((N_D, D_HEADS * HEAD_DIM, D)),
    }


def reference(x_prompt, x_sample, cache_a_k, cache_a_v, cache_b_k, cache_b_v, cache_c_kv, cache_c_krope,
              cache_d_k, cache_d_v, c, c_ctx, mod_w, mod_b, norm_ff1, norm_mix, norm_ff2,
              ff1_w_gu, ff1_w_down, ff2_w_gu, ff2_w_down,
              a_w_qkv, a_q_norm, a_k_norm, a_sink, a_w_o,
              b_w_qkv, b_q_norm, b_k_norm, b_w_o,
              c_w_down, c_q_lnorm, c_kv_lnorm, c_w_uq, c_w_ukv, c_q_norm, c_k_norm, c_w_o,
              d_w_qkv, d_q_norm, d_k_norm, d_rpb, d_w_o):
    xp, xs = x_prompt, x_sample
    n_lat = xs.shape[1]
    ang_hd = grid_angles(n_lat, HEAD_DIM)
    ang_c = grid_angles(n_lat, C_ROPE)
    new_a_k, new_a_v, new_b_k, new_b_v = [], [], [], []
    new_c_kv, new_c_krope, new_d_k, new_d_v = [], [], [], []
    for i in range(DEPTH):
        kind, j = i % N_MIXERS, i // N_MIXERS
        mp = modulation(c_ctx, mod_w[i], mod_b[i])
        ms = [m[:, None, :] for m in modulation(c, mod_w[i], mod_b[i])]
        xp = half_ffn(xp, mp[0], mp[1], mp[2], norm_ff1[i], ff1_w_gu[i], ff1_w_down[i])
        xs = half_ffn(xs, ms[0], ms[1], ms[2], norm_ff1[i], ff1_w_gu[i], ff1_w_down[i])
        hp = modulate(xp, norm_mix[i], mp[3], mp[4])
        hs = modulate(xs, norm_mix[i], ms[3], ms[4])
        if kind == 0:
            q, k, v = gqa_project(hp, a_w_qkv[j], a_q_norm[j], a_k_norm[j], A_HEADS, A_KV_HEADS)
            op = merge_heads(block_attention(group_q(q, A_KV_HEADS), k, v, a_sink[j]), a_w_o[j])
            new_a_k.append(k)
            new_a_v.append(v)
            q, k, v = gqa_project(hs, a_w_qkv[j], a_q_norm[j], a_k_norm[j], A_HEADS, A_KV_HEADS)
            q, k = apply_rope(q, ang_hd), apply_rope(k, ang_hd)
            o = window_attention(group_q(q, A_KV_HEADS), k, v, cache_a_k[:, j], cache_a_v[:, j], a_sink[j])
            os_ = merge_heads(o, a_w_o[j])
        elif kind == 1:
            q, k, v = gqa_project(hp, b_w_qkv[j], b_q_norm[j], b_k_norm[j], B_HEADS, B_KV_HEADS)
            op = merge_heads(block_attention(group_q(q, B_KV_HEADS), k, v), b_w_o[j])
            new_b_k.append(k)
            new_b_v.append(v)
            q, k, v = gqa_project(hs, b_w_qkv[j], b_q_norm[j], b_k_norm[j], B_HEADS, B_KV_HEADS)
            q, k = apply_rope(q, ang_hd), apply_rope(k, ang_hd)
            k_all = jnp.concatenate([k, cache_b_k[:, j]], axis=1)
            v_all = jnp.concatenate([v, cache_b_v[:, j]], axis=1)
            os_ = merge_heads(block_attention(group_q(q, B_KV_HEADS), k_all, v_all), b_w_o[j])
        elif kind == 2:
            cq, ckv, kr = mla_compress(hp, c_w_down[j], c_q_lnorm[j], c_kv_lnorm[j])
            q = mla_queries(cq, c_w_uq[j], c_q_norm[j], None)
            k, v = mla_keys_values(ckv, kr, c_w_ukv[j], c_k_norm[j], None)
            op = merge_heads(block_attention(q, k, v), c_w_o[j])
            new_c_kv.append(ckv)
            new_c_krope.append(kr)
            cq, ckv, kr = mla_compress(hs, c_w_down[j], c_q_lnorm[j], c_kv_lnorm[j])
            q = mla_queries(cq, c_w_uq[j], c_q_norm[j], ang_c)
            k_l, v_l = mla_keys_values(ckv, kr, c_w_ukv[j], c_k_norm[j], ang_c)
            k_c, v_c = mla_keys_values(cache_c_kv[:, j], cache_c_krope[:, j], c_w_ukv[j], c_k_norm[j], None)
            o = block_attention(q, jnp.concatenate([k_l, k_c], axis=1), jnp.concatenate([v_l, v_c], axis=1))
            os_ = merge_heads(o, c_w_o[j])
        else:
            q, k, v = gqa_project(hp, d_w_qkv[j], d_q_norm[j], d_k_norm[j], D_HEADS, D_HEADS)
            op = merge_heads(block_attention(group_q(q, D_HEADS), k, v), d_w_o[j])
            new_d_k.append(k)
            new_d_v.append(v)
            q, k, v = gqa_project(hs, d_w_qkv[j], d_q_norm[j], d_k_norm[j], D_HEADS, D_HEADS)
            o = neighbourhood_attention(q, k, v, cache_d_k[:, j], cache_d_v[:, j], d_rpb[j])
            os_ = merge_heads(o, d_w_o[j])
        xp = xp + mp[5] * op
        xs = xs + ms[5] * os_
        xp = half_ffn(xp, mp[6], mp[7], mp[8], norm_ff2[i], ff2_w_gu[i], ff2_w_down[i])
        xs = half_ffn(xs, ms[6], ms[7], ms[8], norm_ff2[i], ff2_w_gu[i], ff2_w_down[i])
    y_prompt, y_sample = xp, xs
    s_a_k = jnp.stack(new_a_k, axis=1)
    s_a_v = jnp.stack(new_a_v, axis=1)
    s_b_k = jnp.stack(new_b_k, axis=1)
    s_b_v = jnp.stack(new_b_v, axis=1)
    s_c_kv = jnp.stack(new_c_kv, axis=1)
    s_c_krope = jnp.stack(new_c_krope, axis=1)
    s_d_k = jnp.stack(new_d_k, axis=1)
    s_d_v = jnp.stack(new_d_v, axis=1)
    return (y_prompt, y_sample, s_a_k, s_a_v, s_b_k, s_b_v, s_c_kv, s_c_krope, s_d_k, s_d_v)
```

```cpp
#include <hip/hip_runtime.h>
#include <hip/hip_cooperative_groups.h>
#include <cstdio>
#include <cstdint>
namespace cg = cooperative_groups;
namespace pg8 {
#define PG8_LAS __attribute__((address_space(3)))
typedef unsigned short bf16_t;
typedef short bf16x8 __attribute__((ext_vector_type(8)));
typedef float f32x4 __attribute__((ext_vector_type(4)));
typedef unsigned u32x4 __attribute__((ext_vector_type(4)));
constexpr int BM = 256, BK = 64, HALF = 128, HTB = HALF * BK * 2  , STAGE_BYTES = 8 * HTB, NXCD = 8, WGM = 8;

__host__ __device__ __forceinline__ int lds_byte(int r, int c) { const int st = (r >> 4) * 2 + (c >> 5), rr = r & 15, cc = c & 31, ob = rr * 64 + cc * 2; return st * 1024 + (ob ^ (((ob >> 9) & 1) << 5)); }
__host__ __device__ __forceinline__ void stage_rc(int b, int& R, int& C) { const int st = b / 1024, sb = b % 1024, swz = sb ^ (((sb >> 9) & 1) << 5); R = (st >> 1) * 16 + swz / 64; C = (st & 1) * 32 + (swz % 64) / 2; }
__host__ __device__ __forceinline__ int perm32(int rho) { const int n = rho >> 4, i = rho & 15; return 8 * (i >> 2) + 4 * n + (i & 3); }

struct Unit { int pm, pn; };
struct Gemm { const bf16_t* A; const bf16_t* Bt; int M, N, K; };

struct StaticOrder {
    int nM, nN, nwg, G, c;
    __host__ __device__ void init(int M, int N, int G_, int c_) { nM = M / BM; nN = N / BM; nwg = nM * nN; G = G_; c = c_; }
    __host__ __device__ bool next(int i, Unit& u) const {
        const long L = (long)i * G + c; if (L >= nwg) return false;
        int wgid = (int)L; { const int q = nwg / NXCD, r = nwg % NXCD, xcd = wgid % NXCD, off = wgid / NXCD; wgid = (xcd < r ? xcd * (q + 1) : r * (q + 1) + (xcd - r) * q) + off; }
        const int nig = WGM * nN, gid = wgid / nig, fm = gid * WGM, gsz = (nM - fm) < WGM ? (nM - fm) : WGM;
        u.pm = fm + ((wgid % nig) % gsz); u.pn = (wgid % nig) / gsz; return true;
    }
    __device__ __forceinline__ void a_ready(const Unit&) const {}
    __device__ __forceinline__ void done(const Unit&) const {}
};

__device__ __forceinline__ unsigned cvt_pk_bf16(float lo, float hi) { unsigned r; asm volatile("v_cvt_pk_bf16_f32 %0, %1, %2" : "=v"(r) : "v"(lo), "v"(hi)); return r; }
template <class Epi, class Sched, bool ALIGN_EPI = false, bool SP2 = false>
__device__ __forceinline__ void gemm_phase(PG8_LAS unsigned char* lds, const Gemm g, const Sched S, const Epi E, int tid_in) {
    int tid_ = tid_in; asm volatile("" : "+v"(tid_));
    const int tid = tid_, wid = __builtin_amdgcn_readfirstlane(tid >> 6), lane = tid & 63, wr = wid >> 2, wc = wid & 3, fr = lane & 15, fq = lane >> 4;
    const int K = g.K, nt = K / BK;
    unsigned voffA[2], voffB[2];
#pragma unroll
    for (int i = 0; i < 2; ++i) { int R, C; stage_rc(tid * 16 + i * 8192, R, C); const int Rb = Epi::PERM ? ((R & ~31) + perm32(R & 31)) : R;
        voffA[i] = (unsigned)(R * K + C) * 2u; voffB[i] = (unsigned)(Rb * K + C) * 2u; }
    const size_t kstep = (size_t)(BK * 2);
    const size_t hstep = (size_t)HALF * K * 2;
    const size_t tstep = 2 * hstep;
    const unsigned ldsw = (unsigned)wid * 1024u;
    const int aoff = lds_byte(wr * 64 + fr, fq * 8), boff = lds_byte(wc * 32 + fr, fq * 8);
#define PG8_SA(b, h) (((b) * 2 + (h)) * HTB)
#define PG8_SB(b, h) ((4 + (b) * 2 + (h)) * HTB)
#define PG8_STAGE(bufoff, gbase, voff) do { _Pragma("unroll") for (int _i = 0; _i < 2; ++_i) \
        __builtin_amdgcn_global_load_lds((const unsigned*)((const char*)(gbase) + (voff)[_i]), (PG8_LAS unsigned*)(lds + (bufoff) + ldsw + _i * 8192), 16, 0, 0); } while (0)
#define PG8_LDA(dst, b, h) do { _Pragma("unroll") for (int m = 0; m < 4; ++m) _Pragma("unroll") for (int k = 0; k < 2; ++k) dst[m][k] = *(const PG8_LAS bf16x8*)(lds + PG8_SA(b, h) + aoff + m * 2048 + k * 1024); } while (0)
#define PG8_LDB(dst, b, h) do { _Pragma("unroll") for (int n = 0; n < 2; ++n) _Pragma("unroll") for (int k = 0; k < 2; ++k) dst[n][k] = *(const PG8_LAS bf16x8*)(lds + PG8_SB(b, h) + boff + n * 2048 + k * 1024); } while (0)
#define PG8_MMA(ai, bj, At, Bt) do { __builtin_amdgcn_s_setprio(1); _Pragma("unroll") for (int m = 0; m < 4; ++m) _Pragma("unroll") for (int n = 0; n < 2; ++n) _Pragma("unroll") for (int k = 0; k < 2; ++k) \
        acc[ai][bj][m][n] = __builtin_amdgcn_mfma_f32_16x16x32_bf16(Bt[n][k], At[m][k], acc[ai][bj][m][n], 0, 0, 0); __builtin_amdgcn_s_setprio(0); } while (0)
#define PG8_WAIT_V(n) asm volatile("s_waitcnt vmcnt(" #n ")" ::: "memory")
#define PG8_WAIT_L(n) asm volatile("s_waitcnt lgkmcnt(" #n ")" ::: "memory")
#define PG8_BAR __builtin_amdgcn_s_barrier()
#define PG8_SCHED __builtin_amdgcn_sched_barrier(0)
    Unit cur, nxt; int ui = 0;
    if (!S.next(0, cur)) return;
    f32x4 acc[2][2][4][2];
#pragma unroll
    for (int a = 0; a < 2; ++a)
#pragma unroll
        for (int b = 0; b < 2; ++b)
#pragma unroll
            for (int m = 0; m < 4; ++m)
#pragma unroll
                for (int n = 0; n < 2; ++n) acc[a][b][m][n] = (f32x4){0.f, 0.f, 0.f, 0.f};
    bf16x8 At[4][2], B0[2][2], B1[2][2];
    const char* cA = (const char*)g.A + (size_t)cur.pm * tstep; const char* cB = (const char*)g.Bt + (size_t)cur.pn * tstep;
    S.a_ready(cur);
    if constexpr (SP2) {
        PG8_STAGE(PG8_SB(0, 0), cB, voffB); PG8_STAGE(PG8_SB(0, 1), cB + hstep, voffB); PG8_STAGE(PG8_SA(0, 0), cA, voffA); PG8_STAGE(PG8_SA(0, 1), cA + hstep, voffA);
        if (wr == 1) PG8_BAR;
        PG8_WAIT_V(2); PG8_BAR;
        PG8_STAGE(PG8_SB(1, 0), cB + kstep, voffB); PG8_STAGE(PG8_SA(1, 0), cA + kstep, voffA); PG8_STAGE(PG8_SB(1, 1), cB + hstep + kstep, voffB);
        PG8_WAIT_V(6); PG8_BAR;
    } else {
        PG8_STAGE(PG8_SB(0, 0), cB, voffB); PG8_STAGE(PG8_SA(0, 0), cA, voffA); PG8_STAGE(PG8_SB(0, 1), cB + hstep, voffB); PG8_STAGE(PG8_SA(0, 1), cA + hstep, voffA);
        if (wr == 1) PG8_BAR;
        PG8_WAIT_V(4); PG8_BAR;
        PG8_STAGE(PG8_SB(1, 0), cB + kstep, voffB); PG8_STAGE(PG8_SA(1, 0), cA + kstep, voffA); PG8_STAGE(PG8_SB(1, 1), cB + hstep + kstep, voffB);
        PG8_WAIT_V(6); PG8_BAR;
    }
    for (;;) {
        const bool has_next = S.next(ui + 1, nxt);
        const char* nA = has_next ? (const char*)g.A + (size_t)nxt.pm * tstep : cA; const char* nB = has_next ? (const char*)g.Bt + (size_t)nxt.pn * tstep : cB;
        for (int t = 0; t < nt; t += 2) {
            const bool last = (t == nt - 2);
            const char* a1 = cA + (size_t)(t + 1) * kstep;
            const char* a2 = last ? nA : cA + (size_t)(t + 2) * kstep; const char* b2 = last ? nB : cB + (size_t)(t + 2) * kstep;
            const char* a3 = a2 + kstep; const char* b3 = b2 + kstep;
            if (last && has_next) S.a_ready(nxt);
            if constexpr (SP2) {
            PG8_LDB(B0, 0, 0); PG8_LDB(B1, 0, 1); PG8_SCHED; PG8_LDA(At, 0, 0); PG8_STAGE(PG8_SA(1, 1), a1 + hstep, voffA);
            PG8_WAIT_V(8); PG8_WAIT_L(0); PG8_BAR; PG8_MMA(0, 0, At, B0); PG8_MMA(0, 1, At, B1); PG8_BAR; PG8_SCHED;
            PG8_LDA(At, 0, 1); PG8_STAGE(PG8_SB(0, 0), b2, voffB); PG8_STAGE(PG8_SB(0, 1), b2 + hstep, voffB); PG8_STAGE(PG8_SA(0, 0), a2, voffA);
            PG8_WAIT_V(8); PG8_WAIT_L(0); PG8_BAR; PG8_MMA(1, 0, At, B0); PG8_MMA(1, 1, At, B1); PG8_BAR; PG8_SCHED;
            PG8_LDB(B0, 1, 0); PG8_LDB(B1, 1, 1); PG8_SCHED; PG8_LDA(At, 1, 0); PG8_STAGE(PG8_SA(0, 1), a2 + hstep, voffA);
            PG8_WAIT_V(8); PG8_WAIT_L(0); PG8_BAR; PG8_MMA(0, 0, At, B0); PG8_MMA(0, 1, At, B1); PG8_BAR; PG8_SCHED;
            PG8_LDA(At, 1, 1); PG8_STAGE(PG8_SB(1, 0), b3, voffB); PG8_STAGE(PG8_SB(1, 1), b3 + hstep, voffB); PG8_STAGE(PG8_SA(1, 0), a3, voffA);
            PG8_WAIT_V(8); PG8_WAIT_L(0); PG8_BAR; PG8_MMA(1, 0, At, B0); PG8_MMA(1, 1, At, B1); PG8_BAR; PG8_SCHED;
            } else {
            PG8_LDB(B0, 0, 0); PG8_SCHED; PG8_LDA(At, 0, 0); PG8_STAGE(PG8_SA(1, 1), a1 + hstep, voffA);
            PG8_WAIT_L(8); PG8_BAR; PG8_WAIT_L(0); PG8_MMA(0, 0, At, B0); PG8_BAR; PG8_SCHED;
            PG8_LDB(B1, 0, 1); PG8_STAGE(PG8_SB(0, 0), b2, voffB);
            PG8_BAR; PG8_WAIT_L(0); PG8_MMA(0, 1, At, B1); PG8_BAR;
            PG8_LDA(At, 0, 1); PG8_STAGE(PG8_SA(0, 0), a2, voffA);
            PG8_BAR; PG8_WAIT_L(0); PG8_MMA(1, 0, At, B0); PG8_BAR; PG8_SCHED;
            PG8_STAGE(PG8_SB(0, 1), b2 + hstep, voffB);
            PG8_WAIT_V(6); PG8_BAR; PG8_MMA(1, 1, At, B1); PG8_BAR;
            PG8_LDB(B0, 1, 0); PG8_SCHED; PG8_LDA(At, 1, 0); PG8_STAGE(PG8_SA(0, 1), a2 + hstep, voffA);
            PG8_WAIT_L(8); PG8_BAR; PG8_WAIT_L(0); PG8_MMA(0, 0, At, B0); PG8_BAR; PG8_SCHED;
            PG8_LDB(B1, 1, 1); PG8_STAGE(PG8_SB(1, 0), b3, voffB);
            PG8_BAR; PG8_WAIT_L(0); PG8_MMA(0, 1, At, B1); PG8_BAR;
            PG8_LDA(At, 1, 1); PG8_STAGE(PG8_SA(1, 0), a3, voffA);
            PG8_BAR; PG8_WAIT_L(0); PG8_MMA(1, 0, At, B0); PG8_BAR; PG8_SCHED;
            PG8_STAGE(PG8_SB(1, 1), b3 + hstep, voffB);
            PG8_WAIT_V(6); PG8_BAR; PG8_MMA(1, 1, At, B1); PG8_BAR;
            }
        }
        if constexpr (ALIGN_EPI) { if (wr == 0) PG8_BAR; }
        if constexpr (!Epi::AFTER_DRAIN) { E(acc, cur, wr, wc, fr, fq); S.done(cur); }
        if (!has_next) break;
#pragma unroll
        for (int a = 0; a < 2; ++a)
#pragma unroll
            for (int b = 0; b < 2; ++b)
#pragma unroll
                for (int m = 0; m < 4; ++m)
#pragma unroll
                    for (int n = 0; n < 2; ++n) acc[a][b][m][n] = (f32x4){0.f, 0.f, 0.f, 0.f};
        cur = nxt; cA = nA; cB = nB; ++ui;
        if constexpr (ALIGN_EPI) { if (wr == 1) PG8_BAR; }
    }
    PG8_WAIT_V(0);
    if constexpr (!ALIGN_EPI) { if (wr == 0) PG8_BAR; }
    PG8_BAR;
    if constexpr (Epi::AFTER_DRAIN) { E.fused(acc, cur, wr, wc, fr, fq, lds, wid, lane); S.done(cur); }
#undef PG8_SA
#undef PG8_SB
#undef PG8_STAGE
#undef PG8_LDA
#undef PG8_LDB
#undef PG8_MMA
#undef PG8_WAIT_V
#undef PG8_WAIT_L
#undef PG8_BAR
#undef PG8_SCHED
}
}
using pg8::bf16_t; using pg8::f32x4; using pg8::u32x4; using pg8::Unit; using pg8::cvt_pk_bf16;
#define LAS __attribute__((address_space(3)))
#define DI __device__ __forceinline__
#define LDS_WAIT() asm volatile("s_waitcnt lgkmcnt(0)" ::: "memory")
typedef float f32x2 __attribute__((ext_vector_type(2)));
typedef unsigned u32x2 __attribute__((ext_vector_type(2)));

constexpr int D = 1024, MP = 4096, MS = 8192, M = 12288, MALL = 16384;
constexpr int DFF = 2816, NGU = 5632;
constexpr float EPS = 1e-6f;
constexpr float LOG2E = 1.4426950408889634f;
constexpr float QSCALE64 = 0.125f * LOG2E;
constexpr float QSCALE96 = 0.10206207261596575f * LOG2E;
constexpr int NWAVES = 8, NTHR = 512;
constexpr int RING_BYTES = 131072, LDS_BYTES = 147456;

constexpr size_t SZ_WGU = (size_t)NGU * D * 2, SZ_WDN = (size_t)D * DFF * 2;
constexpr size_t O_WGU = 0;
constexpr size_t O_WDN = O_WGU + 8 * SZ_WGU;
constexpr size_t O_WAQKV = O_WDN + 8 * SZ_WDN;
constexpr size_t O_WAO = O_WAQKV + 1536ull * 1024 * 2;
constexpr size_t O_WBQKV = O_WAO + 1024ull * 1024 * 2;
constexpr size_t O_WBO = O_WBQKV + 1536ull * 1024 * 2;
constexpr size_t O_WCDN = O_WBO + 1024ull * 1024 * 2;
constexpr size_t O_WCUQ = O_WCDN + 768ull * 1024 * 2;
constexpr size_t O_WCUKV = O_WCUQ + 1536ull * 384 * 2;
constexpr size_t O_WCO = O_WCUKV + 2048ull * 256 * 2;
constexpr size_t O_WDQKV = O_WCO + 1024ull * 1024 * 2;
constexpr size_t O_WDO = O_WDQKV + 3072ull * 1024 * 2;
constexpr size_t O_XS = O_WDO + 1024ull * 1024 * 2;
constexpr size_t O_ACT = O_XS + (size_t)M * D * 2;
constexpr size_t O_Q = O_ACT + (size_t)M * DFF * 2;
constexpr size_t O_K = O_Q + (size_t)M * 1536 * 2;
constexpr size_t O_V = O_K + (size_t)MALL * 1536 * 2;
constexpr size_t O_OB = O_V + (size_t)MALL * 1024 * 2;
constexpr size_t O_CQS = O_OB + (size_t)M * D * 2;
constexpr size_t O_CKVS = O_CQS + (size_t)M * 384 * 2;
constexpr size_t O_KR = O_CKVS + (size_t)MALL * 256 * 2;
constexpr size_t O_CACHE = O_KR + (size_t)M * 32 * 4;
constexpr size_t O_STATS = O_CACHE + (4ull * 1048576 + 2ull * 4194304) * 2;
constexpr size_t O_CSTATS = O_STATS + (size_t)M * 16 * 4;
constexpr size_t O_MODP = O_CSTATS + (size_t)M * 24 * 4;
constexpr size_t O_MOD = O_MODP + 4ull * 8 * 9 * 9216 * 4;
constexpr size_t O_GS = O_MOD + 4ull * 9 * 9216 * 4;
constexpr size_t O_SHA = O_GS + 4ull * 3 * 9 * 1024 * 4;
constexpr size_t O_BIAS = O_SHA + 12ull * 256 * 1024 * 2;
constexpr size_t O_CSHD = O_BIAS + 12ull * 9 * NGU * 4;
constexpr size_t O_CSC = O_CSHD + 1024ull * 32 * 8;
constexpr size_t O_CTL = O_CSC + 1024ull * 16 * 8;
constexpr size_t WS_NEED = O_CTL + 262144;

constexpr size_t OUT_AK = 12582912, OUT_AV = 13631488, OUT_BK = 14680064, OUT_BV = 15728640, OUT_CKV = 16777216, OUT_CKR = 17825792, OUT_DK = 17956864, OUT_DV = 22151168;

struct Args { const float* in[43]; float* out; unsigned char* ws; int ph_lo, ph_hi; };

DI float bf2f(unsigned short u) { return __builtin_bit_cast(float, (unsigned)u << 16); }
DI float bflo(unsigned w) { return __builtin_bit_cast(float, w << 16); }
DI float bfhi(unsigned w) { return __builtin_bit_cast(float, w & 0xffff0000u); }
DI int mrow_of_tile(int pm) { return pm < 16 ? 0 : 1 + ((pm - 16) >> 2); }
DI float wave_sum(float v) {
#pragma unroll
    for (int o = 1; o < 64; o <<= 1) v += __shfl_xor(v, o);
    return v;
}
DI float sum4(f32x4 a) { return (a.x + a.y) + (a.z + a.w); }
DI float sq4(f32x4 a) { return (a.x * a.x + a.y * a.y) + (a.z * a.z + a.w * a.w); }
DI float row_rs(const float* stats, int row) {
    const f32x4* s = (const f32x4*)(stats + (size_t)row * 16);
    const float t = (sum4(s[0]) + sum4(s[1])) + (sum4(s[2]) + sum4(s[3]));
    return rsqrtf(t * (1.f / 1024.f) + EPS);
}
DI float silu_f(float a) { return a * __builtin_amdgcn_rcpf(1.f + __builtin_amdgcn_exp2f(-a * LOG2E)); }
DI u32x4 pack8(f32x4 a, f32x4 b) { u32x4 w; w.x = cvt_pk_bf16(a.x, a.y); w.y = cvt_pk_bf16(a.z, a.w); w.z = cvt_pk_bf16(b.x, b.y); w.w = cvt_pk_bf16(b.z, b.w); return w; }

struct EpiBias {
    static constexpr bool PERM = true, AFTER_DRAIN = false;
    float* bias;
    DI void operator()(const f32x4 (&acc)[2][2][4][2], const Unit& u, int wr, int wc, int fr, int fq) const {
        int pm_ = u.pm, pn_ = u.pn; asm volatile("" : "+s"(pm_), "+s"(pn_), "+s"(wr), "+s"(wc)); asm volatile("" : "+v"(fr), "+v"(fq));
        if (wr == 0 && fr < 9) {
#pragma unroll
            for (int bj = 0; bj < 2; ++bj) { float* p = bias + (size_t)fr * NGU + pn_ * 256 + bj * 128 + wc * 32 + 8 * fq;
                *(f32x4*)p = acc[0][bj][0][0]; *(f32x4*)(p + 4) = acc[0][bj][0][1]; }
        }
    }
};
struct EpiGU {
    static constexpr bool PERM = true, AFTER_DRAIN = false;
    const float* stats; const float* bias; bf16_t* act;
    DI void operator()(const f32x4 (&acc)[2][2][4][2], const Unit& u, int wr, int wc, int fr, int fq) const {
        int pm_ = u.pm, pn_ = u.pn; asm volatile("" : "+s"(pm_), "+s"(pn_), "+s"(wr), "+s"(wc)); asm volatile("" : "+v"(fr), "+v"(fq));
        const int mr = mrow_of_tile(pm_);
        const float* bp = bias + (size_t)mr * NGU + pn_ * 256 + wc * 32 + 8 * fq;
        const f32x4 ba0 = *(const f32x4*)bp, ba1 = *(const f32x4*)(bp + 4), bu0 = *(const f32x4*)(bp + 128), bu1 = *(const f32x4*)(bp + 132);
#pragma unroll
        for (int ai = 0; ai < 2; ++ai)
#pragma unroll
            for (int m = 0; m < 4; ++m) {
                const int row = pm_ * 256 + ai * 128 + wr * 64 + m * 16 + fr;
                const float rr = row_rs(stats, row);
                const f32x4 a0 = acc[ai][0][m][0] * rr + ba0, a1 = acc[ai][0][m][1] * rr + ba1, u0 = acc[ai][1][m][0] * rr + bu0, u1 = acc[ai][1][m][1] * rr + bu1;
                f32x4 r0, r1;
#pragma unroll
                for (int j = 0; j < 4; ++j) { r0[j] = silu_f(a0[j]) * u0[j]; r1[j] = silu_f(a1[j]) * u1[j]; }
                *(u32x4*)(act + (size_t)row * DFF + pn_ * 128 + wc * 32 + 8 * fq) = pack8(r0, r1);
            }
    }
};
struct EpiRes {
    static constexpr bool PERM = true, AFTER_DRAIN = false;
    float* X; const float* gate; const float* gsn; bf16_t* xs; float* stats; const float* Xr0; const float* Xr1; float gscale; float pad_;
    DI void operator()(const f32x4 (&acc)[2][2][4][2], const Unit& u, int wr, int wc, int fr, int fq) const {
        int pm_ = u.pm, pn_ = u.pn; asm volatile("" : "+s"(pm_), "+s"(pn_), "+s"(wr), "+s"(wc)); asm volatile("" : "+v"(fr), "+v"(fq));
        const int mr = mrow_of_tile(pm_);
        const int c0 = pn_ * 256 + wc * 32 + 8 * fq;
        f32x4 g[2][2], s[2][2];
#pragma unroll
        for (int bj = 0; bj < 2; ++bj) { const float* gp = gate + (size_t)mr * 9216 + c0 + bj * 128; g[bj][0] = *(const f32x4*)gp * gscale; g[bj][1] = *(const f32x4*)(gp + 4) * gscale;
            if (gsn) { const float* sp = gsn + (size_t)mr * 1024 + c0 + bj * 128; s[bj][0] = *(const f32x4*)sp; s[bj][1] = *(const f32x4*)(sp + 4); } else { s[bj][0] = s[bj][1] = (f32x4){0.f, 0.f, 0.f, 0.f}; } }
#pragma unroll
        for (int ai = 0; ai < 2; ++ai)
#pragma unroll
            for (int m = 0; m < 4; ++m) {
                const int row = pm_ * 256 + ai * 128 + wr * 64 + m * 16 + fr;
                float ss = 0.f;
#pragma unroll
                for (int bj = 0; bj < 2; ++bj) {
                    float* xp = X + (size_t)row * D + c0 + bj * 128;
                    const float* xrp = (row < MP ? Xr0 : Xr1) + (size_t)row * D + c0 + bj * 128;
                    f32x4 x0 = *(const f32x4*)xrp, x1 = *(const f32x4*)(xrp + 4);
                    x0 += g[bj][0] * acc[ai][bj][m][0]; x1 += g[bj][1] * acc[ai][bj][m][1];
                    *(f32x4*)xp = x0; *(f32x4*)(xp + 4) = x1;
                    ss += sq4(x0) + sq4(x1);
                    if (gsn) *(u32x4*)(xs + (size_t)row * D + c0 + bj * 128) = pack8(x0 * s[bj][0], x1 * s[bj][1]);
                }
                ss += __shfl_xor(ss, 16); ss += __shfl_xor(ss, 32);
                if (gsn && fq == 0) stats[(size_t)row * 16 + pn_ * 4 + wc] = ss;
            }
    }
};
struct EpiQKV {
    static constexpr bool PERM = true, AFTER_DRAIN = false;
    const float* stats; const float* bias; int nkv; int rope; const float* qg; const float* kg; const float* cs;
    bf16_t* q; bf16_t* k; bf16_t* v; float* ok; float* ov;
    DI void operator()(const f32x4 (&acc)[2][2][4][2], const Unit& u, int wr, int wc, int fr, int fq) const {
        int pm_ = u.pm, pn_ = u.pn; asm volatile("" : "+s"(pm_), "+s"(pn_), "+s"(wr), "+s"(wc)); asm volatile("" : "+v"(fr), "+v"(fq));
        const int mr = mrow_of_tile(pm_);
        const int slot = 4 * pn_ + wc;
        const int type = slot < 16 ? 0 : (slot < 16 + nkv ? 1 : 2);
        const int hh = type == 0 ? slot : (type == 1 ? slot - 16 : slot - 16 - nkv);
        const int kvw = nkv * 64;
        f32x4 b[2][2], gn[2][2];
#pragma unroll
        for (int bj = 0; bj < 2; ++bj) { const float* bp = bias + (size_t)mr * NGU + pn_ * 256 + bj * 128 + wc * 32 + 8 * fq; b[bj][0] = *(const f32x4*)bp; b[bj][1] = *(const f32x4*)(bp + 4);
            const float* gp = (type == 0 ? qg : kg) + 32 * bj + 8 * fq; gn[bj][0] = *(const f32x4*)gp; gn[bj][1] = *(const f32x4*)(gp + 4); }
#pragma unroll
        for (int ai = 0; ai < 2; ++ai)
#pragma unroll
            for (int m = 0; m < 4; ++m) {
                const int row = pm_ * 256 + ai * 128 + wr * 64 + m * 16 + fr;
                const float rr = row_rs(stats, row);
                f32x4 v0[2], v1[2];
#pragma unroll
                for (int bj = 0; bj < 2; ++bj) { v0[bj] = acc[ai][bj][m][0] * rr + b[bj][0]; v1[bj] = acc[ai][bj][m][1] * rr + b[bj][1]; }
                if (type < 2) {
                    float ss = (sq4(v0[0]) + sq4(v1[0])) + (sq4(v0[1]) + sq4(v1[1]));
                    ss += __shfl_xor(ss, 16); ss += __shfl_xor(ss, 32);
                    const float rinv = rsqrtf(ss * (1.f / 64.f) + EPS);
#pragma unroll
                    for (int bj = 0; bj < 2; ++bj) { v0[bj] = v0[bj] * rinv * gn[bj][0]; v1[bj] = v1[bj] * rinv * gn[bj][1]; }
                    if (type == 1 && row < MP) {
#pragma unroll
                        for (int bj = 0; bj < 2; ++bj) { float* op = ok + (size_t)row * kvw + hh * 64 + 32 * bj + 8 * fq; *(f32x4*)op = v0[bj]; *(f32x4*)(op + 4) = v1[bj]; }
                    }
                    if (rope && row >= MP) {
                        const int pos = (row - MP) & 1023;
#pragma unroll
                        for (int bj = 0; bj < 2; ++bj) {
                            const float* cp = cs + ((size_t)pos * 32 + 16 * bj + 4 * fq) * 2;
                            const f32x4 t0 = *(const f32x4*)cp, t1 = *(const f32x4*)(cp + 4);
                            f32x4 a = v0[bj], c = v1[bj];
                            v0[bj] = (f32x4){a.x * t0.x - a.y * t0.y, a.x * t0.y + a.y * t0.x, a.z * t0.z - a.w * t0.w, a.z * t0.w + a.w * t0.z};
                            v1[bj] = (f32x4){c.x * t1.x - c.y * t1.y, c.x * t1.y + c.y * t1.x, c.z * t1.z - c.w * t1.w, c.z * t1.w + c.w * t1.z};
                        }
                    }
                    if (type == 0) {
#pragma unroll
                        for (int bj = 0; bj < 2; ++bj) *(u32x4*)(q + (size_t)row * 1024 + hh * 64 + 32 * bj + 8 * fq) = pack8(v0[bj] * QSCALE64, v1[bj] * QSCALE64);
                    } else {
#pragma unroll
                        for (int bj = 0; bj < 2; ++bj) *(u32x4*)(k + (size_t)row * kvw + hh * 64 + 32 * bj + 8 * fq) = pack8(v0[bj], v1[bj]);
                    }
                } else {
#pragma unroll
                    for (int bj = 0; bj < 2; ++bj) { *(u32x4*)(v + (size_t)row * kvw + hh * 64 + 32 * bj + 8 * fq) = pack8(v0[bj], v1[bj]);
                        if (row < MP) { float* op = ov + (size_t)row * kvw + hh * 64 + 32 * bj + 8 * fq; *(f32x4*)op = v0[bj]; *(f32x4*)(op + 4) = v1[bj]; } }
                }
            }
    }
};
struct EpiCDown {
    static constexpr bool PERM = true, AFTER_DRAIN = false;
    const float* stats; const float* bias; const float* qln; const float* kvln; bf16_t* cqs; bf16_t* ckvs; float* krb; float* cst; float* okv; float* okr;
    DI void operator()(const f32x4 (&acc)[2][2][4][2], const Unit& u, int wr, int wc, int fr, int fq) const {
        int pm_ = u.pm, pn_ = u.pn; asm volatile("" : "+s"(pm_), "+s"(pn_), "+s"(wr), "+s"(wc)); asm volatile("" : "+v"(fr), "+v"(fq));
        const int mr = mrow_of_tile(pm_);
#pragma unroll
        for (int bj = 0; bj < 2; ++bj) {
            const int c0 = pn_ * 256 + bj * 128 + wc * 32 + 8 * fq;
            if (c0 >= 672) continue;
            const float* bp = bias + (size_t)mr * NGU + c0;
            const f32x4 b0 = *(const f32x4*)bp, b1 = *(const f32x4*)(bp + 4);
            const int reg = c0 < 384 ? 0 : (c0 < 640 ? 1 : 2);
            f32x4 g0 = (f32x4){1.f, 1.f, 1.f, 1.f}, g1 = g0;
            if (reg == 0) { g0 = *(const f32x4*)(qln + c0); g1 = *(const f32x4*)(qln + c0 + 4); }
            if (reg == 1) { g0 = *(const f32x4*)(kvln + c0 - 384); g1 = *(const f32x4*)(kvln + c0 - 380); }
#pragma unroll
            for (int ai = 0; ai < 2; ++ai)
#pragma unroll
                for (int m = 0; m < 4; ++m) {
                const int row = pm_ * 256 + ai * 128 + wr * 64 + m * 16 + fr;
                    const float rr = row_rs(stats, row);
                    const f32x4 v0 = acc[ai][bj][m][0] * rr + b0, v1 = acc[ai][bj][m][1] * rr + b1;
                    float ss = sq4(v0) + sq4(v1);
                    ss += __shfl_xor(ss, 16); ss += __shfl_xor(ss, 32);
                    if (fq == 0) cst[(size_t)row * 24 + pn_ * 8 + bj * 4 + wc] = ss;
                    if (reg == 0) *(u32x4*)(cqs + (size_t)row * 384 + c0) = pack8(v0 * g0, v1 * g1);
                    else if (reg == 1) { const f32x4 w0 = v0 * g0, w1 = v1 * g1; *(u32x4*)(ckvs + (size_t)row * 256 + c0 - 384) = pack8(w0, w1);
                        if (row < MP) { float* op = okv + (size_t)row * 256 + c0 - 384; *(f32x4*)op = w0; *(f32x4*)(op + 4) = w1; } }
                    else { float* kp = krb + (size_t)row * 32 + c0 - 640; *(f32x4*)kp = v0; *(f32x4*)(kp + 4) = v1;
                        if (row < MP) { float* op = okr + (size_t)row * 32 + c0 - 640; *(f32x4*)op = v0; *(f32x4*)(op + 4) = v1; } }
                }
        }
    }
};
DI float cst_sum(const float* cst, int row, int lo, int cnt4) {
    const f32x4* s = (const f32x4*)(cst + (size_t)row * 24 + lo); float t = 0.f;
    for (int i = 0; i < cnt4; ++i) t += sum4(s[i]);
    return t;
}
struct EpiUQ {
    static constexpr bool PERM = true, AFTER_DRAIN = false;
    const float* cst; bf16_t* qraw;
    DI void operator()(const f32x4 (&acc)[2][2][4][2], const Unit& u, int wr, int wc, int fr, int fq) const {
        int pm_ = u.pm, pn_ = u.pn; asm volatile("" : "+s"(pm_), "+s"(pn_), "+s"(wr), "+s"(wc)); asm volatile("" : "+v"(fr), "+v"(fq));
#pragma unroll
        for (int ai = 0; ai < 2; ++ai)
#pragma unroll
            for (int m = 0; m < 4; ++m) {
                const int row = pm_ * 256 + ai * 128 + wr * 64 + m * 16 + fr;
                const float rq = rsqrtf(cst_sum(cst, row, 0, 3) * (1.f / 384.f) + EPS);
#pragma unroll
                for (int bj = 0; bj < 2; ++bj) *(u32x4*)(qraw + (size_t)row * 1536 + pn_ * 256 + bj * 128 + wc * 32 + 8 * fq) = pack8(acc[ai][bj][m][0] * rq, acc[ai][bj][m][1] * rq);
            }
    }
};
struct EpiUKV {
    static constexpr bool PERM = true, AFTER_DRAIN = false;
    const float* cst; const float* krb; const float* krc; const float* kg; const float* cs; bf16_t* kk; bf16_t* vv;
    DI void operator()(const f32x4 (&acc)[2][2][4][2], const Unit& u, int wr, int wc, int fr, int fq) const {
        int pm_ = u.pm, pn_ = u.pn; asm volatile("" : "+s"(pm_), "+s"(pn_), "+s"(wr), "+s"(wc)); asm volatile("" : "+v"(fr), "+v"(fq));
        const int slot = 4 * pn_ + wc, h = slot >> 1, part = slot & 1;
        f32x4 gn[2][2], gr0, gr1;
#pragma unroll
        for (int bj = 0; bj < 2; ++bj) { gn[bj][0] = *(const f32x4*)(kg + 32 * bj + 8 * fq); gn[bj][1] = *(const f32x4*)(kg + 32 * bj + 8 * fq + 4); }
        gr0 = *(const f32x4*)(kg + 64 + 8 * fq); gr1 = *(const f32x4*)(kg + 68 + 8 * fq);
#pragma unroll
        for (int ai = 0; ai < 2; ++ai)
#pragma unroll
            for (int m = 0; m < 4; ++m) {
                const int row = pm_ * 256 + ai * 128 + wr * 64 + m * 16 + fr;
                const float rkv = row < M ? rsqrtf(cst_sum(cst, row, 12, 2) * (1.f / 256.f) + EPS) : 1.f;
                f32x4 v0[2], v1[2];
#pragma unroll
                for (int bj = 0; bj < 2; ++bj) { v0[bj] = acc[ai][bj][m][0] * rkv; v1[bj] = acc[ai][bj][m][1] * rkv; }
                if (part == 1) {
#pragma unroll
                    for (int bj = 0; bj < 2; ++bj) *(u32x4*)(vv + (size_t)row * 1024 + h * 64 + 32 * bj + 8 * fq) = pack8(v0[bj], v1[bj]);
                } else {
                    const float* kp = (row < M ? krb + (size_t)row * 32 : krc + (size_t)(row - M) * 32) + 8 * fq;
                    f32x4 k0 = *(const f32x4*)kp, k1 = *(const f32x4*)(kp + 4);
                    float ss = (sq4(v0[0]) + sq4(v1[0])) + (sq4(v0[1]) + sq4(v1[1])) + (sq4(k0) + sq4(k1));
                    ss += __shfl_xor(ss, 16); ss += __shfl_xor(ss, 32);
                    const float rk = rsqrtf(ss * (1.f / 96.f) + EPS);
#pragma unroll
                    for (int bj = 0; bj < 2; ++bj) *(u32x4*)(kk + (size_t)row * 1536 + h * 96 + 32 * bj + 8 * fq) = pack8(v0[bj] * rk * gn[bj][0], v1[bj] * rk * gn[bj][1]);
                    k0 = k0 * rk * gr0; k1 = k1 * rk * gr1;
                    if (row >= MP && row < M) {
                        const int pos = (row - MP) & 1023;
                        const float* cp = cs + ((size_t)pos * 16 + 4 * fq) * 2;
                        const f32x4 t0 = *(const f32x4*)cp, t1 = *(const f32x4*)(cp + 4);
                        const f32x4 a = k0, c = k1;
                        k0 = (f32x4){a.x * t0.x - a.y * t0.y, a.x * t0.y + a.y * t0.x, a.z * t0.z - a.w * t0.w, a.z * t0.w + a.w * t0.z};
                        k1 = (f32x4){c.x * t1.x - c.y * t1.y, c.x * t1.y + c.y * t1.x, c.z * t1.z - c.w * t1.w, c.z * t1.w + c.w * t1.z};
                    }
                    *(u32x4*)(kk + (size_t)row * 1536 + h * 96 + 64 + 8 * fq) = pack8(k0, k1);
                }
            }
    }
};
DI void transpose_item(const float* W, int K, int N, bf16_t* WT, int perm, int item, int lane) {
    const int nblk = N / 32, kb = item / nblk, nb = item % nblk, k0 = 64 * kb, n0 = 32 * nb;
    const int kg = lane >> 3, ng = lane & 7;
    const float* src = W + (size_t)(k0 + 8 * kg) * N + n0 + 4 * ng;
    f32x4 v[8];
#pragma unroll
    for (int kk = 0; kk < 8; ++kk) v[kk] = *(const f32x4*)(src + (size_t)kk * N);
    int r0 = n0;
    if (perm == 1) { const int j = n0 < DFF ? n0 : n0 - DFF; r0 = 256 * (j >> 7) + (n0 < DFF ? 0 : 128) + (j & 127); }
    else if (perm == 2) { const int slot = n0 >> 6, d = n0 & 63; r0 = 256 * (slot >> 2) + 128 * (d >> 5) + 32 * (slot & 3); }
    bf16_t* dst = WT + (size_t)(r0 + 4 * ng) * K + k0 + 8 * kg;
#pragma unroll
    for (int j = 0; j < 4; ++j) { u32x4 o; o.x = cvt_pk_bf16(v[0][j], v[1][j]); o.y = cvt_pk_bf16(v[2][j], v[3][j]); o.z = cvt_pk_bf16(v[4][j], v[5][j]); o.w = cvt_pk_bf16(v[6][j], v[7][j]);
        *(u32x4*)(dst + (size_t)j * K) = o; }
}
DI void cvt_range(const float* src, bf16_t* dst, size_t n8, size_t gt, size_t ngt) {
    for (size_t i = gt; i < n8; i += ngt) { const f32x4 a = *(const f32x4*)(src + i * 8), b = *(const f32x4*)(src + i * 8 + 4); *(u32x4*)(dst + i * 8) = pack8(a, b); }
}
DI float modval(const float* modp, const float* modb, int l, int r, int n) {
    float t = modb[l * 9216 + n];
#pragma unroll
    for (int kc = 0; kc < 8; ++kc) t += modp[((size_t)(l * 8 + kc) * 9 + r) * 9216 + n];
    return t;
}
DI void sincos_d(double ang, float& c, float& s) {
    const double k = __builtin_rint(ang * 0.15915494309189535);
    const double r = ang - k * 6.283185307179586;
    const double x2 = r * r;
    double P = 1.0, Q = 1.0;
#pragma unroll
    for (int i = 14; i >= 1; --i) { P = 1.0 - P * x2 * (1.0 / (double)((2 * i) * (2 * i + 1))); Q = 1.0 - Q * x2 * (1.0 / (double)((2 * i - 1) * (2 * i))); }
    s = (float)(r * P); c = (float)Q;
}

template <int DK>
DI void akey(const float (&q)[DK], float (&o)[64], float& m, float& l, const bf16_t* kp, const bf16_t* vp, float bias, bool valid) {
    float s = bias;
#pragma unroll
    for (int c = 0; c < DK / 8; ++c) { const u32x4 w = ((const u32x4*)kp)[c];
        s += q[8 * c] * bflo(w.x) + q[8 * c + 1] * bfhi(w.x) + q[8 * c + 2] * bflo(w.y) + q[8 * c + 3] * bfhi(w.y) + q[8 * c + 4] * bflo(w.z) + q[8 * c + 5] * bfhi(w.z) + q[8 * c + 6] * bflo(w.w) + q[8 * c + 7] * bfhi(w.w); }
    if (valid) {
        const float mn = fmaxf(m, s), al = __builtin_amdgcn_exp2f(m - mn), p = __builtin_amdgcn_exp2f(s - mn);
        l = l * al + p; m = mn;
#pragma unroll
        for (int c = 0; c < 8; ++c) { const u32x4 w = ((const u32x4*)vp)[c];
            o[8 * c] = o[8 * c] * al + p * bflo(w.x); o[8 * c + 1] = o[8 * c + 1] * al + p * bfhi(w.x); o[8 * c + 2] = o[8 * c + 2] * al + p * bflo(w.y); o[8 * c + 3] = o[8 * c + 3] * al + p * bfhi(w.y);
            o[8 * c + 4] = o[8 * c + 4] * al + p * bflo(w.z); o[8 * c + 5] = o[8 * c + 5] * al + p * bfhi(w.z); o[8 * c + 6] = o[8 * c + 6] * al + p * bflo(w.w); o[8 * c + 7] = o[8 * c + 7] * al + p * bfhi(w.w); }
    }
}
template <int MODE>
DI void attn_naive(const bf16_t* Q, const bf16_t* K, const bf16_t* V, const bf16_t* CK, const bf16_t* CV, bf16_t* O,
                   const float* sink, const float* rpb, const float* cqg, const float* csc, int gw, int ngw, int lane) {
    constexpr int DK = MODE == 2 ? 96 : 64;
    constexpr int G = (MODE <= 1) ? 4 : 1;
    constexpr int KS = MODE <= 1 ? 256 : (MODE == 2 ? 1536 : 1024);
    constexpr int VS = MODE <= 1 ? 256 : 1024;
    constexpr int QS = MODE == 2 ? 1536 : 1024;
    for (int it = gw; it < 3072; it += ngw) {
        const int h = it & 15, rbi = it >> 4, rb = rbi < 128 ? 64 + rbi : rbi - 128;
        const int row = rb * 64 + lane, kvh = h / G;
        const bool samp = rb >= 64;
        const int b = samp ? (rb - 64) >> 4 : rb >> 2, p0 = samp ? ((rb - 64) & 15) * 64 : 0, qpos = p0 + lane;
        float q[DK], o[64];
        { const u32x4* qp = (const u32x4*)(Q + (size_t)row * QS + h * DK);
#pragma unroll
          for (int c = 0; c < DK / 8; ++c) { const u32x4 w = qp[c]; q[8 * c] = bflo(w.x); q[8 * c + 1] = bfhi(w.x); q[8 * c + 2] = bflo(w.y); q[8 * c + 3] = bfhi(w.y); q[8 * c + 4] = bflo(w.z); q[8 * c + 5] = bfhi(w.z); q[8 * c + 6] = bflo(w.w); q[8 * c + 7] = bfhi(w.w); } }
        if (MODE == 2) {
            float ss = 0.f;
#pragma unroll
            for (int d = 0; d < DK; ++d) ss += q[d] * q[d];
            const float rinv = rsqrtf(ss * (1.f / 96.f) + EPS);
#pragma unroll
            for (int d = 0; d < DK; ++d) q[d] = q[d] * rinv * cqg[d];
            if (samp) {
#pragma unroll
                for (int i = 0; i < 16; ++i) { const f32x2 t = *(const f32x2*)(csc + ((size_t)qpos * 16 + i) * 2); const float x0 = q[64 + 2 * i], x1 = q[65 + 2 * i]; q[64 + 2 * i] = x0 * t.x - x1 * t.y; q[65 + 2 * i] = x0 * t.y + x1 * t.x; }
            }
#pragma unroll
            for (int d = 0; d < DK; ++d) q[d] *= QSCALE96;
        }
#pragma unroll
        for (int d = 0; d < 64; ++d) o[d] = 0.f;
        float m = -1e30f, l = 0.f;
        if (MODE == 0) { m = sink[h] * LOG2E; l = 1.f; }
        if (!samp) {
            const bf16_t* kb = K + (size_t)(b * 256) * KS + kvh * DK; const bf16_t* vb = V + (size_t)(b * 256) * VS + kvh * 64;
            for (int j = 0; j < 256; ++j) akey<DK>(q, o, m, l, kb + (size_t)j * KS, vb + (size_t)j * VS, 0.f, true);
        } else {
            const bf16_t* kb = K + (size_t)(MP + b * 1024) * KS + kvh * DK; const bf16_t* vb = V + (size_t)(MP + b * 1024) * VS + kvh * 64;
            if (MODE == 0) {
                const int lo = p0 - 128 < 0 ? 0 : p0 - 128, hi = p0 + 192 > 1024 ? 1024 : p0 + 192;
                for (int j = lo; j < hi; ++j) { const int dd = qpos - j; akey<DK>(q, o, m, l, kb + (size_t)j * KS, vb + (size_t)j * VS, 0.f, dd <= 128 && dd >= -128); }
            } else if (MODE == 3) {
                const int r = p0 >> 6, rs = r - 4 < 0 ? 0 : (r - 4 > 8 ? 8 : r - 4);
                const int cs0 = lane - 8 < 0 ? 0 : (lane - 8 > 48 ? 48 : lane - 8);
                for (int j = rs * 64; j < rs * 64 + 512; ++j) { const int kr = j >> 6, kc = j & 63; const bool valid = kc >= cs0 && kc < cs0 + 16;
                    const float bias = valid ? rpb[(h * 15 + (kr - r + 7)) * 31 + (kc - lane + 15)] * LOG2E : 0.f;
                    akey<DK>(q, o, m, l, kb + (size_t)j * KS, vb + (size_t)j * VS, bias, valid); }
            } else {
                for (int j = 0; j < 1024; ++j) akey<DK>(q, o, m, l, kb + (size_t)j * KS, vb + (size_t)j * VS, 0.f, true);
            }
            const bf16_t* ckb = CK + (size_t)(b * 512) * KS + kvh * DK; const bf16_t* cvb = CV + (size_t)(b * 512) * VS + kvh * 64;
            for (int j = 0; j < 512; ++j) akey<DK>(q, o, m, l, ckb + (size_t)j * KS, cvb + (size_t)j * VS, 0.f, true);
        }
        const float il = 1.f / l;
        u32x4* op = (u32x4*)(O + (size_t)row * 1024 + h * 64);
#pragma unroll
        for (int c = 0; c < 8; ++c) { u32x4 w; w.x = cvt_pk_bf16(o[8 * c] * il, o[8 * c + 1] * il); w.y = cvt_pk_bf16(o[8 * c + 2] * il, o[8 * c + 3] * il); w.z = cvt_pk_bf16(o[8 * c + 4] * il, o[8 * c + 5] * il); w.w = cvt_pk_bf16(o[8 * c + 6] * il, o[8 * c + 7] * il); op[c] = w; }
    }
}
typedef short bf16x8_t __attribute__((ext_vector_type(8)));
typedef float f32x16 __attribute__((ext_vector_type(16)));
typedef __bf16 bf16x2_t __attribute__((ext_vector_type(2)));
typedef short s16x4 __attribute__((ext_vector_type(4)));
typedef short v4i16_t __attribute__((ext_vector_type(4)));
DI unsigned cvtpk(float lo, float hi) { f32x2 v = {lo, hi}; bf16x2_t b = __builtin_convertvector(v, bf16x2_t); return __builtin_bit_cast(unsigned, b); }
DI s16x4 vtr(LAS unsigned char* p) { return __builtin_bit_cast(s16x4, __builtin_amdgcn_ds_read_tr16_b64_v4i16((LAS v4i16_t*)p)); }
DI int crow16(int i, int hh) { return (i & 3) + 8 * (i >> 2) + 4 * hh; }
DI int clampi(int v, int lo, int hi) { return v < lo ? lo : (v > hi ? hi : v); }

template <int MODE>
DI void attn_mfma(const bf16_t* Q, const bf16_t* K, const bf16_t* V, const bf16_t* CK, const bf16_t* CV, bf16_t* O,
                  const float* sink, const float* rpb, const float* cqg, const float* csc, LAS unsigned char* lds, int bx, int G, int tid, int wave) {
    constexpr int DK = MODE == 2 ? 96 : 64;
    constexpr int KS = MODE <= 1 ? 256 : (MODE == 2 ? 1536 : 1024);
    constexpr int VS = MODE <= 1 ? 256 : 1024;
    constexpr int QS = MODE == 2 ? 1536 : 1024;
    constexpr int KROWB = DK * 2 + 16, VROWB = 144, KBUF = 64 * KROWB, VBUF = 64 * VROWB;
    constexpr int OFF_V = 2 * KBUF, OFF_RPB = OFF_V + 2 * VBUF;
    constexpr int NS = DK / 16;
    const int lane = tid & 63, r = lane & 31, hh = lane >> 5;
    const int i16 = lane & 15, tq = i16 >> 2, tp = i16 & 3, tblk = (lane >> 4) & 1;
    LAS float* rpbL = (LAS float*)(lds + OFF_RPB);
    for (int item = bx; item < 768; item += G) {
        const bool samp = item < 512;
        int b, kvh, p0, head, q0;
        if (MODE <= 1) {
            if (samp) { b = item >> 6; kvh = (item >> 4) & 3; p0 = (item & 15) * 64; } else { const int j = item - 512; b = j >> 4; kvh = (j >> 2) & 3; p0 = (j & 3) * 64; }
            head = kvh * 4 + (wave >> 1); q0 = p0 + 32 * (wave & 1);
        } else {
            if (samp) { b = item >> 6; head = (item >> 2) & 15; p0 = (item & 3) * 256; } else { const int j = item - 512; b = j >> 4; head = j & 15; p0 = 0; }
            kvh = head; q0 = p0 + 32 * wave;
        }
        const int rowbase = samp ? MP + b * 1024 : b * 256;
        const int qrow = rowbase + q0 + r, qpos = q0 + r;
        bf16x8_t qf[NS];
        if (MODE != 2) {
#pragma unroll
            for (int s = 0; s < NS; ++s) qf[s] = *(const bf16x8_t*)(Q + (size_t)qrow * QS + head * DK + 16 * s + 8 * hh);
        } else {
            float v[NS][8]; float ss = 0.f;
#pragma unroll
            for (int s = 0; s < NS; ++s) { const u32x4 w = *(const u32x4*)(Q + (size_t)qrow * QS + head * DK + 16 * s + 8 * hh);
                v[s][0] = bflo(w.x); v[s][1] = bfhi(w.x); v[s][2] = bflo(w.y); v[s][3] = bfhi(w.y); v[s][4] = bflo(w.z); v[s][5] = bfhi(w.z); v[s][6] = bflo(w.w); v[s][7] = bfhi(w.w);
#pragma unroll
                for (int j = 0; j < 8; ++j) ss += v[s][j] * v[s][j]; }
            ss += __shfl_xor(ss, 32);
            const float rinv = rsqrtf(ss * (1.f / 96.f) + EPS) ;
#pragma unroll
            for (int s = 0; s < NS; ++s) { const f32x4 g0 = *(const f32x4*)(cqg + 16 * s + 8 * hh), g1 = *(const f32x4*)(cqg + 16 * s + 8 * hh + 4);
#pragma unroll
                for (int j = 0; j < 4; ++j) { v[s][j] *= rinv * g0[j]; v[s][4 + j] *= rinv * g1[j]; }
                if (s >= 4 && samp) {
                    const float* cp = csc + ((size_t)qpos * 16 + 8 * (s - 4) + 4 * hh) * 2;
                    const f32x4 t0 = *(const f32x4*)cp, t1 = *(const f32x4*)(cp + 4);
                    float a0 = v[s][0], a1 = v[s][1]; v[s][0] = a0 * t0.x - a1 * t0.y; v[s][1] = a0 * t0.y + a1 * t0.x;
                    a0 = v[s][2]; a1 = v[s][3]; v[s][2] = a0 * t0.z - a1 * t0.w; v[s][3] = a0 * t0.w + a1 * t0.z;
                    a0 = v[s][4]; a1 = v[s][5]; v[s][4] = a0 * t1.x - a1 * t1.y; v[s][5] = a0 * t1.y + a1 * t1.x;
                    a0 = v[s][6]; a1 = v[s][7]; v[s][6] = a0 * t1.z - a1 * t1.w; v[s][7] = a0 * t1.w + a1 * t1.z;
                }
                u32x4 w; w.x = cvtpk(v[s][0] * QSCALE96, v[s][1] * QSCALE96); w.y = cvtpk(v[s][2] * QSCALE96, v[s][3] * QSCALE96); w.z = cvtpk(v[s][4] * QSCALE96, v[s][5] * QSCALE96); w.w = cvtpk(v[s][6] * QSCALE96, v[s][7] * QSCALE96);
                qf[s] = __builtin_bit_cast(bf16x8_t, w); }
        }
        int nlat, lat0, klo = 0, ncache = samp ? 8 : 0;
        if (!samp) { lat0 = rowbase; nlat = 4; }
        else if (MODE == 0) { const int lo = p0 - 128 < 0 ? 0 : p0 - 128, hi = p0 + 192 > 1024 ? 1024 : p0 + 192; lat0 = rowbase + lo; nlat = (hi - lo) >> 6; klo = lo; }
        else if (MODE == 3) { const int r0 = p0 >> 6, lo = clampi(r0 - 4, 0, 8), hi = clampi(r0 - 1, 0, 8) + 8; lat0 = rowbase + lo * 64; nlat = hi - lo; klo = lo; }
        else { lat0 = rowbase; nlat = 16; }
        const int nt = nlat + ncache;
        if (MODE == 3) { for (int i = tid; i < 465; i += NTHR) rpbL[i] = rpb[head * 465 + i] * LOG2E; }
        u32x4 kst0, kst1, vst;
        const int kkey0 = DK == 64 ? tid >> 3 : tid / 12, kc0 = DK == 64 ? tid & 7 : tid % 12;
        const int kkey1 = (tid + 512) / 12, kc1 = (tid + 512) % 12;
        const int vkey = tid >> 3, vc = tid & 7;
#define ATT_LOAD(T) do { const int t_ = (T); const bf16_t* kp_; const bf16_t* vp_; \
            if (t_ < nlat) { kp_ = K + (size_t)(lat0 + 64 * t_) * KS + kvh * DK; vp_ = V + (size_t)(lat0 + 64 * t_) * VS + kvh * 64; } \
            else { kp_ = CK + (size_t)(b * 512 + 64 * (t_ - nlat)) * KS + kvh * DK; vp_ = CV + (size_t)(b * 512 + 64 * (t_ - nlat)) * VS + kvh * 64; } \
            kst0 = *(const u32x4*)(kp_ + (size_t)kkey0 * KS + kc0 * 8); \
            if (DK == 96 && tid < 256) kst1 = *(const u32x4*)(kp_ + (size_t)kkey1 * KS + kc1 * 8); \
            vst = *(const u32x4*)(vp_ + (size_t)vkey * VS + vc * 8); } while (0)
#define ATT_STORE(B) do { LAS unsigned char* kb_ = lds + (B) * KBUF; LAS unsigned char* vb_ = lds + OFF_V + (B) * VBUF; \
            *(LAS u32x4*)(kb_ + kkey0 * KROWB + kc0 * 16) = kst0; \
            if (DK == 96 && tid < 256) *(LAS u32x4*)(kb_ + kkey1 * KROWB + kc1 * 16) = kst1; \
            *(LAS u32x4*)(vb_ + vkey * VROWB + vc * 16) = vst; } while (0)
        ATT_LOAD(0); ATT_STORE(0);
        __syncthreads();
        f32x16 o0, o1;
#pragma unroll
        for (int i = 0; i < 16; ++i) { o0[i] = 0.f; o1[i] = 0.f; }
        float l = 0.f;
        if (MODE == 0) l = hh == 0 ? __builtin_amdgcn_exp2f(sink[head] * LOG2E) : 0.f;
        const int rq = (q0 >> 6), qc = (q0 & 63) + r, rsw = clampi(rq - 4, 0, 8), cs0 = clampi(qc - 8, 0, 48);
        for (int t = 0; t < nt; ++t) {
            if (t + 1 < nt) ATT_LOAD(t + 1);
            LAS unsigned char* kbuf = lds + (t & 1) * KBUF; LAS unsigned char* vbuf = lds + OFF_V + (t & 1) * VBUF;
            const bool lat = samp && t < nlat;
            bool active = true;
            if (MODE == 3 && lat) { const int kr = klo + t; active = kr >= rsw && kr < rsw + 8; }
            if (active) {
                f32x16 s0, s1;
#pragma unroll
                for (int i = 0; i < 16; ++i) { s0[i] = 0.f; s1[i] = 0.f; }
#pragma unroll
                for (int s = 0; s < NS; ++s) {
                    const bf16x8_t k0 = *(LAS bf16x8_t*)(kbuf + r * KROWB + (16 * s + 8 * hh) * 2);
                    const bf16x8_t k1 = *(LAS bf16x8_t*)(kbuf + (32 + r) * KROWB + (16 * s + 8 * hh) * 2);
                    s0 = __builtin_amdgcn_mfma_f32_32x32x16_bf16(k0, qf[s], s0, 0, 0, 0);
                    s1 = __builtin_amdgcn_mfma_f32_32x32x16_bf16(k1, qf[s], s1, 0, 0, 0);
                }
                if (MODE == 0 && lat) {
                    const int kbase = klo + 64 * t;
                    if (kbase + 63 - q0 > 128 || q0 + 31 - kbase > 128) {
#pragma unroll
                        for (int i = 0; i < 16; ++i) { const int d0 = qpos - (kbase + crow16(i, hh)), d1 = d0 - 32;
                            if (d0 > 128 || d0 < -128) s0[i] = -INFINITY; if (d1 > 128 || d1 < -128) s1[i] = -INFINITY; }
                    }
                }
                if (MODE == 3 && lat) {
                    const int kr = klo + t; const LAS float* rp = rpbL + (kr - rq + 7) * 31 + 15 - qc;
#pragma unroll
                    for (int i = 0; i < 16; ++i) { const int kc = crow16(i, hh), kc2 = kc + 32;
                        const bool v0 = kc >= cs0 && kc < cs0 + 16, v1 = kc2 >= cs0 && kc2 < cs0 + 16;
                        const float b0 = rp[clampi(kc, qc - 15, qc + 15)], b1 = rp[clampi(kc2, qc - 15, qc + 15)];
                        s0[i] = v0 ? s0[i] + b0 : -INFINITY; s1[i] = v1 ? s1[i] + b1 : -INFINITY; }
                }
                float rs = 0.f;
#pragma unroll
                for (int i = 0; i < 16; ++i) { s0[i] = __builtin_amdgcn_exp2f(s0[i]); s1[i] = __builtin_amdgcn_exp2f(s1[i]); rs += s0[i] + s1[i]; }
                l += rs;
#pragma unroll
                for (int kb = 0; kb < 2; ++kb)
#pragma unroll
                    for (int s2 = 0; s2 < 2; ++s2) {
                        u32x4 pw;
                        if (kb == 0) { pw.x = cvtpk(s0[8 * s2], s0[8 * s2 + 1]); pw.y = cvtpk(s0[8 * s2 + 2], s0[8 * s2 + 3]); pw.z = cvtpk(s0[8 * s2 + 4], s0[8 * s2 + 5]); pw.w = cvtpk(s0[8 * s2 + 6], s0[8 * s2 + 7]); }
                        else { pw.x = cvtpk(s1[8 * s2], s1[8 * s2 + 1]); pw.y = cvtpk(s1[8 * s2 + 2], s1[8 * s2 + 3]); pw.z = cvtpk(s1[8 * s2 + 4], s1[8 * s2 + 5]); pw.w = cvtpk(s1[8 * s2 + 6], s1[8 * s2 + 7]); }
                        const bf16x8_t pb = __builtin_bit_cast(bf16x8_t, pw);
                        LAS unsigned char* vp = vbuf + (32 * kb + 16 * s2 + 4 * hh + tq) * VROWB + (16 * tblk + 4 * tp) * 2;
                        const s16x4 a0 = vtr(vp), a1 = vtr(vp + 8 * VROWB), c0 = vtr(vp + 64), c1 = vtr(vp + 8 * VROWB + 64);
                        const bf16x8_t vf0 = __builtin_shufflevector(a0, a1, 0, 1, 2, 3, 4, 5, 6, 7), vf1 = __builtin_shufflevector(c0, c1, 0, 1, 2, 3, 4, 5, 6, 7);
                        o0 = __builtin_amdgcn_mfma_f32_32x32x16_bf16(vf0, pb, o0, 0, 0, 0);
                        o1 = __builtin_amdgcn_mfma_f32_32x32x16_bf16(vf1, pb, o1, 0, 0, 0);
                    }
            }
            if (t + 1 < nt) ATT_STORE((t + 1) & 1);
            __syncthreads();
        }
#undef ATT_LOAD
#undef ATT_STORE
        l += __shfl_xor(l, 32);
        const float il = 1.f / l;
        bf16_t* op = O + (size_t)qrow * 1024 + head * 64 + 4 * hh;
#pragma unroll
        for (int g = 0; g < 4; ++g) {
            u32x2 w0, w1;
            w0.x = cvtpk(o0[4 * g] * il, o0[4 * g + 1] * il); w0.y = cvtpk(o0[4 * g + 2] * il, o0[4 * g + 3] * il);
            w1.x = cvtpk(o1[4 * g] * il, o1[4 * g + 1] * il); w1.y = cvtpk(o1[4 * g + 2] * il, o1[4 * g + 3] * il);
            *(u32x2*)(op + 8 * g) = w0; *(u32x2*)(op + 32 + 8 * g) = w1;
        }
    }
}
__constant__ double q4[4] = {1.0, 0.5623413251903491, 0.31622776601683794, 0.1778279410038923};
__constant__ double p10[4] = {1.0, 0.1, 0.01, 0.001};
#ifndef SITE_MASK
#define SITE_MASK 0xff
#endif
#define SITE(n) (((SITE_MASK) >> (n)) & 1)
#ifndef REP_MASK
#define REP_MASK 0
#endif
#ifndef NAIVE_ATTN
#define NAIVE_ATTN 0
#endif
#if NAIVE_ATTN
#define ATTN attn_naive
#define ATTN_TAIL gw, ngw, lane
#else
#define ATTN attn_mfma
#define ATTN_TAIL lds, bx, G, tid, wave
#endif
#ifndef NOATTN
#define NOATTN 0
#endif
#ifndef NOP0
#define NOP0 0
#endif
#define PGALIGN true
#define PGSP2 true
#define XB_TMO      128
#define XB_XCNT(j)  (256  + 64 * (j))
#define XB_XSUB(j)  (1280 + 64 * (j))
#define XB_XGEN(j)  (2304 + 64 * (j))
#define XB_TOP      3328
#define XB_TOPGEN   3392
#define XB_SPIN_CAP (1u << 20)
DI unsigned xb_ld(unsigned* p) { return __hip_atomic_load(p, __ATOMIC_RELAXED, __HIP_MEMORY_SCOPE_AGENT); }
DI unsigned xb_add(unsigned* p, unsigned v) { return __hip_atomic_fetch_add(p, v, __ATOMIC_RELAXED, __HIP_MEMORY_SCOPE_AGENT); }
DI unsigned xb_xcc_id() { return (unsigned)__builtin_amdgcn_s_getreg((3 << 11) | 20) & 0xFu; }
#define XB_SPIN(cond, bar) do { unsigned _sp = 0; while (cond) { __builtin_amdgcn_s_sleep(1); \
    if ((++_sp & 255u) == 0u) { if (xb_ld(&(bar)[XB_TMO])) break; if (_sp > XB_SPIN_CAP) { atomicAdd(&(bar)[XB_TMO], 1u); break; } } } } while (0)
DI void xcd_barrier_complete(unsigned* bar, unsigned x, unsigned G, unsigned& nloc, unsigned& nx) {
    unsigned sum, cnt, mine, sp = 0u;
    for (;;) {
        sum = 0u; cnt = 0u; mine = 0u;
#pragma unroll
        for (unsigned j = 0; j < 16; ++j) { const unsigned c = xb_ld(&bar[XB_XCNT(j)]); sum += c; cnt += (c > 0u) ? 1u : 0u; mine = (j == x) ? c : mine; }
        if (sum == G) break;
        __builtin_amdgcn_s_sleep(1);
        if ((++sp & 255u) == 0u) { if (xb_ld(&bar[XB_TMO])) break; if (sp > XB_SPIN_CAP) { atomicAdd(&bar[XB_TMO], 1u); break; } }
    }
    nloc = mine > 0u ? mine : 1u; nx = cnt > 0u ? cnt : 1u;
}
DI void grid_bar(unsigned* bar, volatile LAS unsigned* st, int tid) {
    asm volatile("s_waitcnt vmcnt(0)" ::: "memory");
    __syncthreads();
    if (tid == 0) {
        __builtin_amdgcn_s_waitcnt(0);
        const unsigned x = xb_xcc_id();
        unsigned nloc = st[0], nx = st[1];
        if (nloc == 0u) { xcd_barrier_complete(bar, x, gridDim.x, nloc, nx); st[0] = nloc; st[1] = nx; }
        const unsigned old = xb_add(&bar[XB_XSUB(x)], 1u);
        const unsigned gen = old / nloc;
        if (old + 1u == (gen + 1u) * nloc) {
            __builtin_amdgcn_fence(__ATOMIC_RELEASE, "agent");
            asm volatile("s_waitcnt vmcnt(0)" ::: "memory");
            const unsigned og = xb_add(&bar[XB_TOP], 1u);
            const unsigned tg = og / nx;
            if (og + 1u == (tg + 1u) * nx) xb_add(&bar[XB_TOPGEN], 1u);
            else XB_SPIN(xb_ld(&bar[XB_TOPGEN]) == tg, bar);
            __builtin_amdgcn_fence(__ATOMIC_ACQUIRE, "agent");
            xb_add(&bar[XB_XGEN(x)], 1u);
            asm volatile("s_waitcnt vmcnt(0)" ::: "memory");
        } else {
            XB_SPIN(xb_ld(&bar[XB_XGEN(x)]) == gen, bar);
            __builtin_amdgcn_fence(__ATOMIC_ACQUIRE, "agent");
            asm volatile("s_waitcnt vmcnt(0)" ::: "memory");
        }
    }
    __syncthreads();
}
constexpr size_t CTL_HEAD_OFF = 16384, CTL_CNT_OFF = 32768, CTL_BYTES = 262144;
struct QueueOrder {
    unsigned* head; const unsigned* dep; unsigned need; unsigned* pub;
    int lo, hi, ntn, gsz, x, first; int* carry; volatile LAS int* mail; int wave, lane;
    DI void decode(int t, pg8::Unit& u) const { const int j = t - lo, per = gsz * ntn, g = j / per, r = j - g * per; u.pn = r / gsz; u.pm = x + 8 * (g * gsz + (r - u.pn * gsz)); }
    DI bool next(int i, pg8::Unit& u) const {
        int t = first, ready = 1;
        if (i != 0) {
            if (i == 1 && wave == 0) {
                int tt = 0;
                if (lane == 0) tt = (int)__hip_atomic_fetch_add(head, 1u, __ATOMIC_RELAXED, __HIP_MEMORY_SCOPE_AGENT);
                tt = __builtin_amdgcn_readfirstlane(tt);
                int rd = 1;
                if (tt < hi && dep) { pg8::Unit v; decode(tt, v); if (v.pm < 48) rd = __builtin_amdgcn_readfirstlane((int)(__hip_atomic_load(dep + 16 * v.pm, __ATOMIC_RELAXED, __HIP_MEMORY_SCOPE_AGENT) >= need)); }
                if (lane == 0) { mail[0] = tt; mail[1] = rd; mail[2] = 0; }
                asm volatile("s_waitcnt vmcnt(0) lgkmcnt(0)" ::: "memory");
            }
            asm volatile("" ::: "memory"); __builtin_amdgcn_s_barrier(); asm volatile("" ::: "memory");
            t = __builtin_amdgcn_readfirstlane(mail[0]); ready = __builtin_amdgcn_readfirstlane(mail[1]);
            *carry = t;
            if (t >= hi || !ready) { if (wave == 0 && lane == 0) mail[2] = 1; return false; }
            decode(t, u); return true;
        }
        decode(t, u); return true;
    }
    DI void a_ready(const pg8::Unit& u) const {
        if (dep && u.pm < 48) {
            if (wave == 0) {
                unsigned sp = 0;
                while ((unsigned)__builtin_amdgcn_readfirstlane((int)__hip_atomic_load(dep + 16 * u.pm, __ATOMIC_RELAXED, __HIP_MEMORY_SCOPE_AGENT)) < need) { __builtin_amdgcn_s_sleep(2); if (++sp > (1u << 22)) break; }
                __builtin_amdgcn_fence(__ATOMIC_ACQUIRE, "agent");
                asm volatile("s_waitcnt vmcnt(0)" ::: "memory");
            }
            asm volatile("" ::: "memory"); __builtin_amdgcn_s_barrier(); asm volatile("" ::: "memory");
        }
    }
    DI void done(const pg8::Unit& u) const {
        const int holding = __builtin_amdgcn_readfirstlane(mail[2]);
        int tt = 0;
        if (!holding && wave == 0 && lane == 0) tt = (int)__hip_atomic_fetch_add(head, 1u, __ATOMIC_RELAXED, __HIP_MEMORY_SCOPE_AGENT);
        asm volatile("s_waitcnt vmcnt(0)" : "+v"(tt) :: "memory");
        if (pub && lane == 0) (void)__hip_atomic_fetch_add(pub + 16 * u.pm, 1u, __ATOMIC_RELAXED, __HIP_MEMORY_SCOPE_AGENT);
        if (!holding && wave == 0) {
            tt = __builtin_amdgcn_readfirstlane(tt);
            int rd = 1;
            if (tt < hi && dep) { pg8::Unit v; decode(tt, v); if (v.pm < 48) rd = __builtin_amdgcn_readfirstlane((int)(__hip_atomic_load(dep + 16 * v.pm, __ATOMIC_RELAXED, __HIP_MEMORY_SCOPE_AGENT) >= need)); }
            if (lane == 0) { mail[0] = tt; mail[1] = rd; }
            asm volatile("s_waitcnt vmcnt(0) lgkmcnt(0)" ::: "memory");
        }
    }
};
template <class Epi>
DI void run_stage(LAS unsigned char* lds, int& t, int lo, int ntn, int npan, const bf16_t* A, const bf16_t* Bt, int Mrows, int K, const Epi& E,
                  unsigned* head, const unsigned* dep, unsigned need, unsigned* pub, int x, int wave_s) {
    const int hi = lo + ntn * npan;
    while (t >= lo && t < hi) {
        int tid = wave_s * 64 + (int)__builtin_amdgcn_mbcnt_hi(~0u, __builtin_amdgcn_mbcnt_lo(~0u, 0u)); asm volatile("" : "+v"(tid));
        QueueOrder S{head, dep, need, pub, lo, hi, ntn, npan / 2, x, t, &t, (volatile LAS int*)(lds + RING_BYTES + 1024), wave_s, tid & 63};
        pg8::Gemm gg{A, Bt, Mrows, ntn * 256, K};
        pg8::gemm_phase<Epi, QueueOrder, PGALIGN, PGSP2>(lds, gg, S, E, tid);
    }
}
template <int ph> DI bool run_phase(const Args& a, LAS unsigned char* lds, int wave_s) {
        bool did = true;
        int tid = wave_s * 64 + (int)__builtin_amdgcn_mbcnt_hi(~0u, __builtin_amdgcn_mbcnt_lo(~0u, 0u)); asm volatile("" : "+v"(tid));
        int bx = blockIdx.x; asm volatile("" : "+s"(bx));
        const int lane = tid & 63, wave = wave_s;
        const int G = gridDim.x;
        const int gw = bx * NWAVES + wave, ngw = G * NWAVES;
        const size_t gt = (size_t)bx * NTHR + tid, ngt = (size_t)G * NTHR;
    unsigned char* ws = a.ws; asm volatile("" : "+s"(ws));
    float* X = a.out; asm volatile("" : "+s"(X));
    bf16_t* xs = (bf16_t*)(ws + O_XS); bf16_t* act = (bf16_t*)(ws + O_ACT); bf16_t* qb = (bf16_t*)(ws + O_Q); bf16_t* kb = (bf16_t*)(ws + O_K); bf16_t* vb = (bf16_t*)(ws + O_V);
    bf16_t* ob = (bf16_t*)(ws + O_OB); bf16_t* cqs = (bf16_t*)(ws + O_CQS); bf16_t* ckvs = (bf16_t*)(ws + O_CKVS); float* krb = (float*)(ws + O_KR);
    bf16_t* cache = (bf16_t*)(ws + O_CACHE); float* stats = (float*)(ws + O_STATS); float* cst = (float*)(ws + O_CSTATS);
    float* modp = (float*)(ws + O_MODP); float* mod = (float*)(ws + O_MOD); float* gs = (float*)(ws + O_GS); bf16_t* sha = (bf16_t*)(ws + O_SHA); float* bias = (float*)(ws + O_BIAS);
    float* cshd = (float*)(ws + O_CSHD); float* csc = (float*)(ws + O_CSC);

        if (ph == 0 && !NOP0) {
            LAS float* scr = (LAS float*)(lds + wave * 16384);
            constexpr int I_GU = 16 * 176, I_DN = 44 * 32, I_L = 2 * (I_GU + I_DN);
            constexpr int I_AQ = 16 * 48, I_O = 16 * 32, I_CD = 16 * 21, I_CUQ = 6 * 48, I_CUKV = 4 * 64, I_DQ = 16 * 96;
            constexpr int NIT = 4 * I_L + 2 * (I_AQ + I_O) + I_CD + I_CUQ + I_CUKV + I_O + I_DQ + I_O;
#define TR(SRC, KK, NN, PERM, DST, CNT) { if (r < (CNT)) { transpose_item((SRC), (KK), (NN), (bf16_t*)(ws + (DST)), (PERM), r, lane); continue; } r -= (CNT); }
            for (int it = gw; it < NIT; it += ngw) {
                int r = it;
                if (r < 4 * I_L) { const int l = r / I_L; r -= l * I_L;
                    TR(a.in[17] + (size_t)l * D * NGU, D, NGU, 1, O_WGU + (size_t)(2 * l) * SZ_WGU, I_GU)
                    TR(a.in[19] + (size_t)l * D * NGU, D, NGU, 1, O_WGU + (size_t)(2 * l + 1) * SZ_WGU, I_GU)
                    TR(a.in[18] + (size_t)l * DFF * D, DFF, D, 0, O_WDN + (size_t)(2 * l) * SZ_WDN, I_DN)
                    TR(a.in[20] + (size_t)l * DFF * D, DFF, D, 0, O_WDN + (size_t)(2 * l + 1) * SZ_WDN, I_DN)
                    continue; }
                r -= 4 * I_L;
                TR(a.in[21], D, 1536, 2, O_WAQKV, I_AQ)
                TR(a.in[25], D, D, 0, O_WAO, I_O)
                TR(a.in[26], D, 1536, 2, O_WBQKV, I_AQ)
                TR(a.in[29], D, D, 0, O_WBO, I_O)
                TR(a.in[30], D, 672, 0, O_WCDN, I_CD)
                TR(a.in[33], 384, 1536, 0, O_WCUQ, I_CUQ)
                TR(a.in[34], 256, 2048, 2, O_WCUKV, I_CUKV)
                TR(a.in[37], D, D, 0, O_WCO, I_O)
                TR(a.in[38], D, 3072, 2, O_WDQKV, I_DQ)
                TR(a.in[42], D, D, 0, O_WDO, I_O)
            }
#undef TR
            for (int it = gw; it < 4 * 36 * 8; it += ngw) {
                const int l = it / 288, rem = it % 288, nb = rem >> 3, kc = rem & 7, k0 = kc * 128, n0 = nb * 256 + lane * 4;
                for (int idx = lane; idx < 9 * 128; idx += 64) { const int r = idx >> 7, kk = idx & 127; const float c = r == 0 ? a.in[11][k0 + kk] : a.in[10][(r - 1) * D + k0 + kk]; scr[idx] = silu_f(c); }
                LDS_WAIT(); asm volatile("" ::: "memory");
                f32x4 ac[9];
#pragma unroll
                for (int r = 0; r < 9; ++r) ac[r] = (f32x4){0.f, 0.f, 0.f, 0.f};
                const float* wp = a.in[12] + ((size_t)l * D + k0) * 9216 + n0;
#pragma unroll 8
                for (int kk = 0; kk < 128; ++kk) { const f32x4 w = *(const f32x4*)(wp + (size_t)kk * 9216);
#pragma unroll
                    for (int r = 0; r < 9; ++r) ac[r] += w * scr[r * 128 + kk]; }
#pragma unroll
                for (int r = 0; r < 9; ++r) *(f32x4*)(modp + ((size_t)(l * 8 + kc) * 9 + r) * 9216 + n0) = ac[r];
                LDS_WAIT(); asm volatile("" ::: "memory");
            }
            cvt_range(a.in[2], cache, 131072, gt, ngt); cvt_range(a.in[3], cache + 1048576, 131072, gt, ngt);
            cvt_range(a.in[4], cache + 2 * 1048576, 131072, gt, ngt); cvt_range(a.in[5], cache + 3 * 1048576, 131072, gt, ngt);
            cvt_range(a.in[8], cache + 4 * 1048576, 524288, gt, ngt); cvt_range(a.in[9], cache + 8 * 1048576, 524288, gt, ngt);
            cvt_range(a.in[6], ckvs + (size_t)M * 256, 131072, gt, ngt);
            for (size_t i = gt; i < 1024 * 48; i += ngt) {
                const int pos = (int)(i / 48), t = (int)(i % 48);
                double ang; float c, s;
                if (t < 32) { const int ii = t & 15; ang = (double)(t < 16 ? pos >> 6 : pos & 63) * (q4[ii & 3] * p10[ii >> 2]); sincos_d(ang, c, s); cshd[((size_t)pos * 32 + t) * 2] = c; cshd[((size_t)pos * 32 + t) * 2 + 1] = s; }
                else { const int t2 = t - 32, ii = t2 & 7; ang = (double)(t2 < 8 ? pos >> 6 : pos & 63) * (q4[(ii & 1) * 2] * p10[ii >> 1]); sincos_d(ang, c, s); csc[((size_t)pos * 16 + t2) * 2] = c; csc[((size_t)pos * 16 + t2) * 2 + 1] = s; }
            }
        } else if (ph == 1) {
            for (size_t i = gt; i < 4 * 9 * 9216; i += ngt) { const int l = (int)(i / (9 * 9216)), r = (int)((i / 9216) % 9), n = (int)(i % 9216); mod[i] = modval(modp, a.in[13], l, r, n); }
            for (size_t i = gt; i < 4 * 3 * 9 * 1024; i += ngt) {
                const int k = (int)(i & 1023), r = (int)((i >> 10) % 9), nm = (int)((i / 9216) % 3), l = (int)(i / 27648);
                const float g = a.in[14 + nm][l * D + k];
                gs[i] = g * (1.f + modval(modp, a.in[13], l, r, (3 * nm + 1) * 1024 + k));
                const float sh = modval(modp, a.in[13], l, r, (3 * nm) * 1024 + k);
                sha[((size_t)(l * 3 + nm) * 256 + r) * 1024 + k] = (bf16_t)(cvt_pk_bf16(sh, 0.f) & 0xffffu);
            }
        } else if (ph == 2) {
            int off = 0;
            for (int g = 0; g < 12; ++g) {
                const int l = g / 3, nm = g % 3;
                const bf16_t* Bt; int N;
                if (nm != 1) { Bt = (const bf16_t*)(ws + O_WGU + (size_t)(2 * l + (nm == 2)) * SZ_WGU); N = NGU; }
                else if (l == 0) { Bt = (const bf16_t*)(ws + O_WAQKV); N = 1536; } else if (l == 1) { Bt = (const bf16_t*)(ws + O_WBQKV); N = 1536; }
                else if (l == 2) { Bt = (const bf16_t*)(ws + O_WCDN); N = 768; } else { Bt = (const bf16_t*)(ws + O_WDQKV); N = 3072; }
                pg8::Gemm gg{sha + (size_t)g * 256 * 1024, Bt, 256, N, D}; pg8::StaticOrder S; S.init(256, N, G, (bx + G - (off % G)) % G);
                EpiBias E{bias + (size_t)g * 9 * NGU};
                if (SITE(0)) pg8::gemm_phase<EpiBias, pg8::StaticOrder, PGALIGN, PGSP2>(lds, gg, S, E, tid);
                off += N / 256;
            }
            for (int m = gw; m < M; m += ngw) {
                const int mr = mrow_of_tile(m >> 8);
                const f32x4* xr = (const f32x4*)(m < MP ? a.in[0] + (size_t)m * D : a.in[1] + (size_t)(m - MP) * D) + lane; const f32x4* gr = (const f32x4*)(gs + (size_t)mr * 1024) + lane;
                float ss = 0.f;
#pragma unroll
                for (int j = 0; j < 4; ++j) { const f32x4 v = xr[64 * j], g4 = gr[64 * j]; ss += sq4(v); const f32x4 w = v * g4;
                    u32x2 o; o.x = cvt_pk_bf16(w.x, w.y); o.y = cvt_pk_bf16(w.z, w.w); *((u32x2*)(xs + (size_t)m * D) + lane + 64 * j) = o; }
                ss = wave_sum(ss);
                if (lane < 16) stats[(size_t)m * 16 + lane] = lane == 0 ? ss : 0.f;
            }
        } else if ((ph & 1) == 0) {
            constexpr int l = (ph - 4) >> 1;
            if (l == 2) { float* okv = a.out + OUT_CKV;
                for (int m = gw; m < MP; m += ngw) { const float r = rsqrtf(cst_sum(cst, m, 12, 2) * (1.f / 256.f) + EPS); f32x4* p = (f32x4*)(okv + (size_t)m * 256) + lane; *p = *p * r; } }
            if (l == 0) ATTN<0>(qb, kb, vb, cache, cache + 1048576, ob, a.in[24], nullptr, nullptr, nullptr, ATTN_TAIL);
            else if (l == 1) ATTN<1>(qb, kb, vb, cache + 2 * 1048576, cache + 3 * 1048576, ob, nullptr, nullptr, nullptr, nullptr, ATTN_TAIL);
            else if (l == 2) ATTN<2>(qb, kb, vb, kb + (size_t)M * 1536, vb + (size_t)M * 1024, ob, nullptr, nullptr, a.in[35], csc, ATTN_TAIL);
            else ATTN<3>(qb, kb, vb, cache + 4 * 1048576, cache + 8 * 1048576, ob, nullptr, a.in[41], nullptr, nullptr, ATTN_TAIL);
        } else {
            constexpr int sg = (ph - 3) >> 1;
            const int x = (int)(xb_xcc_id() & 7u);
            unsigned* ctl = (unsigned*)(ws + O_CTL);
            unsigned* head = ctl + CTL_HEAD_OFF / 4 + (sg * 8 + x) * 64;
            unsigned* cntb = ctl + CTL_CNT_OFF / 4 + (size_t)(sg * 10) * 64 * 16;
            volatile LAS int* mail = (volatile LAS int*)(lds + RING_BYTES + 1024);
            if (wave == 0) { int tt = 0; if (lane == 0) tt = (int)__hip_atomic_fetch_add(head, 1u, __ATOMIC_RELAXED, __HIP_MEMORY_SCOPE_AGENT); tt = __builtin_amdgcn_readfirstlane(tt); if (lane == 0) mail[0] = tt; }
            __syncthreads();
            int t = __builtin_amdgcn_readfirstlane(mail[0]);
            __syncthreads();
            int lo = 0, k = 0; const unsigned* dep = nullptr; unsigned need = 0;
#define STAGE_ADV(NTN, NPAN) do { lo += (NTN) * (NPAN); dep = cntb + (size_t)k * 64 * 16; need = 8u * (NTN); ++k; } while (0)
            if (sg >= 1) {
                constexpr int l = sg - 1;
                const float* modl = mod + (size_t)l * 9 * 9216;
                { EpiRes E{X, modl + 5 * 1024, gs + (size_t)(l * 3 + 2) * 9 * 1024, xs, stats, X, X, 1.f, 0.f};
                  run_stage<EpiRes>(lds, t, lo, 4, 6, ob, (const bf16_t*)(ws + (l == 0 ? O_WAO : l == 1 ? O_WBO : l == 2 ? O_WCO : O_WDO)), M, D, E, head, dep, need, cntb + (size_t)k * 64 * 16, x, wave_s); STAGE_ADV(4, 6); }
                { EpiGU E{stats, bias + (size_t)(l * 3 + 2) * 9 * NGU, act};
                  run_stage<EpiGU>(lds, t, lo, 22, 6, xs, (const bf16_t*)(ws + O_WGU + (size_t)(2 * l + 1) * SZ_WGU), M, D, E, head, dep, need, cntb + (size_t)k * 64 * 16, x, wave_s); STAGE_ADV(22, 6); }
                { EpiRes E{X, modl + 8 * 1024, l < 3 ? gs + (size_t)((l + 1) * 3) * 9 * 1024 : nullptr, xs, stats, X, X, 0.5f, 0.f};
                  run_stage<EpiRes>(lds, t, lo, 4, 6, act, (const bf16_t*)(ws + O_WDN + (size_t)(2 * l + 1) * SZ_WDN), M, DFF, E, head, dep, need, sg <= 3 ? cntb + (size_t)k * 64 * 16 : nullptr, x, wave_s); STAGE_ADV(4, 6); }
            }
            if (sg <= 3) {
                constexpr int l = sg;
                const float* modl = mod + (size_t)l * 9 * 9216;
                { EpiGU E{stats, bias + (size_t)(l * 3) * 9 * NGU, act};
                  run_stage<EpiGU>(lds, t, lo, 22, 6, xs, (const bf16_t*)(ws + O_WGU + (size_t)(2 * l) * SZ_WGU), M, D, E, head, dep, need, cntb + (size_t)k * 64 * 16, x, wave_s); STAGE_ADV(22, 6); }
                { EpiRes E{X, modl + 2 * 1024, gs + (size_t)(l * 3 + 1) * 9 * 1024, xs, stats, sg == 0 ? a.in[0] : X, sg == 0 ? a.in[1] - (size_t)MP * D : X, 0.5f, 0.f};
                  run_stage<EpiRes>(lds, t, lo, 4, 6, act, (const bf16_t*)(ws + O_WDN + (size_t)(2 * l) * SZ_WDN), M, DFF, E, head, dep, need, cntb + (size_t)k * 64 * 16, x, wave_s); STAGE_ADV(4, 6); }
                const float* bl = bias + (size_t)(l * 3 + 1) * 9 * NGU;
                if (l == 2) {
                    { EpiCDown E{stats, bl, a.in[31], a.in[32], cqs, ckvs, krb, cst, a.out + OUT_CKV, a.out + OUT_CKR};
                      run_stage<EpiCDown>(lds, t, lo, 3, 6, xs, (const bf16_t*)(ws + O_WCDN), M, D, E, head, dep, need, cntb + (size_t)k * 64 * 16, x, wave_s); STAGE_ADV(3, 6); }
                    { int kq = 384; asm volatile("" : "+s"(kq));
                      EpiUQ E{cst, qb};
                      run_stage<EpiUQ>(lds, t, lo, 6, 6, cqs, (const bf16_t*)(ws + O_WCUQ), M, kq, E, head, dep, need, nullptr, x, wave_s); lo += 36; ++k; }
                    { int kkv = 256; asm volatile("" : "+s"(kkv));
                      EpiUKV E{cst, krb, a.in[7], a.in[36], csc, kb, vb};
                      run_stage<EpiUKV>(lds, t, lo, 8, 8, ckvs, (const bf16_t*)(ws + O_WCUKV), MALL, kkv, E, head, dep, need, nullptr, x, wave_s); lo += 64; ++k; }
                } else {
                    constexpr int nkv = l == 3 ? 16 : 4; constexpr int ntn = (1024 + 2 * nkv * 64) / 256;
                    const bf16_t* Bt = (const bf16_t*)(ws + (l == 0 ? O_WAQKV : l == 1 ? O_WBQKV : O_WDQKV));
                    float* ok = a.out + (l == 0 ? OUT_AK : l == 1 ? OUT_BK : OUT_DK); float* ov = a.out + (l == 0 ? OUT_AV : l == 1 ? OUT_BV : OUT_DV);
                    const float* qg = l == 0 ? a.in[22] : l == 1 ? a.in[27] : a.in[39]; const float* kg = l == 0 ? a.in[23] : l == 1 ? a.in[28] : a.in[40];
                    EpiQKV E{stats, bl, nkv, l < 2 ? 1 : 0, qg, kg, cshd, qb, kb, vb, ok, ov};
                    run_stage<EpiQKV>(lds, t, lo, ntn, 6, xs, Bt, M, D, E, head, dep, need, nullptr, x, wave_s); lo += ntn * 6; ++k;
                }
            }
#undef STAGE_ADV
        }
        return did;
}
template <int PH> DI void run_all(const Args& a, LAS unsigned char* lds, int wave_s, unsigned& nbar) {
    if constexpr (PH < 12) {
        if (a.ph_lo <= PH && PH < a.ph_hi) {
            const bool did = run_phase<PH>(a, lds, wave_s);
#if 0
            { constexpr bool rep = (PH >= 4 && PH != 8 && (PH & 1) == 0 && (REP_MASK & 4)) || (PH == 2 && (REP_MASK & 32)) || (PH == 1 && (REP_MASK & 64));
              if constexpr (rep) { __syncthreads(); (void)run_phase<PH>(a, lds, wave_s); } }
#endif
            if (did && PH + 1 < a.ph_hi) { const int tid = wave_s * 64 + (int)__builtin_amdgcn_mbcnt_hi(~0u, __builtin_amdgcn_mbcnt_lo(~0u, 0u)); grid_bar((unsigned*)(a.ws + O_CTL), (volatile LAS unsigned*)(lds + RING_BYTES + 320), tid); }
        }
        run_all<PH + 1>(a, lds, wave_s, nbar);
    }
}
__global__ void __launch_bounds__(NTHR, 2) mega(Args a) {
    extern __shared__ __attribute__((aligned(16))) unsigned char lds_raw[];
    LAS unsigned char* lds = (LAS unsigned char*)lds_raw;
    if (a.ph_hi < 0) { cg::grid_group grid = cg::this_grid(); grid.sync(); }
    const int wave_s = __builtin_amdgcn_readfirstlane(threadIdx.x >> 6);
    unsigned nbar = 0;
    if (threadIdx.x < 64) ((LAS unsigned*)(lds + RING_BYTES))[threadIdx.x + 64] = 0u;
    __syncthreads();
    if (threadIdx.x == 0) (void)xb_add((unsigned*)(a.ws + O_CTL) + XB_XCNT(xb_xcc_id()), 1u);
    run_all<0>(a, lds, wave_s, nbar);
}

constexpr int N_PHASES = 12;
extern "C" void kernel_launch(void* const* d_in, const int* in_sizes, int n_in, void* d_out, int out_size, void* d_ws, size_t ws_size, hipStream_t stream) {
    static int grid = 0;
    if (grid == 0) {
        if (n_in != 43 || ws_size < WS_NEED || out_size != 26345472) { fprintf(stderr, "kernel_launch: unexpected problem shape (n_in %d, out %d, ws %zu need %zu)\n", n_in, out_size, ws_size, (size_t)WS_NEED); grid = -1; return; }
        int dev = 0, cus = 0, per_cu = 0;
        hipGetDevice(&dev); hipDeviceGetAttribute(&cus, hipDeviceAttributeMultiprocessorCount, dev);
        if (hipFuncSetAttribute((const void*)mega, hipFuncAttributeMaxDynamicSharedMemorySize, LDS_BYTES) != hipSuccess) { fprintf(stderr, "kernel_launch: hipFuncSetAttribute failed\n"); grid = -1; return; }
        if (hipOccupancyMaxActiveBlocksPerMultiprocessor(&per_cu, (const void*)mega, NTHR, LDS_BYTES) != hipSuccess || per_cu < 1) { fprintf(stderr, "kernel_launch: occupancy query says %d\n", per_cu); per_cu = 1; }
        (void)hipGetLastError();
        grid = cus * 1;
        if (grid <= 0) grid = 256;
    }
    if (grid < 0) return;
    if (hipMemsetAsync((char*)d_ws + O_CTL, 0, CTL_BYTES, stream) != hipSuccess) { fprintf(stderr, "kernel_launch: memset failed\n"); return; }
    Args a{};
    for (int i = 0; i < 43; ++i) a.in[i] = (const float*)d_in[i];
    a.out = (float*)d_out; a.ws = (unsigned char*)d_ws; a.ph_lo = 0; a.ph_hi = N_PHASES;
    void* args[] = {&a};
    hipError_t e = hipLaunchCooperativeKernel((const void*)mega, dim3(grid), dim3(NTHR), args, LDS_BYTES, stream);
    if (e != hipSuccess) fprintf(stderr, "kernel_launch: cooperative launch failed: %s (grid %d)\n", hipGetErrorString(e), grid);
}
```

```cpp
#include <hip/hip_runtime.h>
#include <hip/hip_cooperative_groups.h>
#include <cstdio>
#include <cstdint>
namespace cg = cooperative_groups;
namespace pg8 {
#define PG8_LAS __attribute__((address_space(3)))
typedef unsigned short bf16_t;
typedef short bf16x8 __attribute__((ext_vector_type(8)));
typedef float f32x4 __attribute__((ext_vector_type(4)));
typedef unsigned u32x4 __attribute__((ext_vector_type(4)));
constexpr int BM = 256, BK = 64, HALF = 128, HTB = HALF * BK * 2  , STAGE_BYTES = 8 * HTB, NXCD = 8, WGM = 8;

__host__ __device__ __forceinline__ int lds_byte(int r, int c) { const int st = (r >> 4) * 2 + (c >> 5), rr = r & 15, cc = c & 31, ob = rr * 64 + cc * 2; return st * 1024 + (ob ^ (((ob >> 9) & 1) << 5)); }
__host__ __device__ __forceinline__ void stage_rc(int b, int& R, int& C) { const int st = b / 1024, sb = b % 1024, swz = sb ^ (((sb >> 9) & 1) << 5); R = (st >> 1) * 16 + swz / 64; C = (st & 1) * 32 + (swz % 64) / 2; }
__host__ __device__ __forceinline__ int perm32(int rho) { const int n = rho >> 4, i = rho & 15; return 8 * (i >> 2) + 4 * n + (i & 3); }

struct Unit { int pm, pn; };
struct Gemm { const bf16_t* A; const bf16_t* Bt; int M, N, K; };

struct StaticOrder {
    int nM, nN, nwg, G, c;
    __host__ __device__ void init(int M, int N, int G_, int c_) { nM = M / BM; nN = N / BM; nwg = nM * nN; G = G_; c = c_; }
    __host__ __device__ bool next(int i, Unit& u) const {
        const long L = (long)i * G + c; if (L >= nwg) return false;
        int wgid = (int)L; { const int q = nwg / NXCD, r = nwg % NXCD, xcd = wgid % NXCD, off = wgid / NXCD; wgid = (xcd < r ? xcd * (q + 1) : r * (q + 1) + (xcd - r) * q) + off; }
        const int nig = WGM * nN, gid = wgid / nig, fm = gid * WGM, gsz = (nM - fm) < WGM ? (nM - fm) : WGM;
        u.pm = fm + ((wgid % nig) % gsz); u.pn = (wgid % nig) / gsz; return true;
    }
    __device__ __forceinline__ void a_ready(const Unit&) const {}
    __device__ __forceinline__ void done(const Unit&) const {}
};

__device__ __forceinline__ unsigned cvt_pk_bf16(float lo, float hi) { unsigned r; asm volatile("v_cvt_pk_bf16_f32 %0, %1, %2" : "=v"(r) : "v"(lo), "v"(hi)); return r; }
template <class Epi, class Sched, bool ALIGN_EPI = false, bool SP2 = false>
__device__ __forceinline__ void gemm_phase(PG8_LAS unsigned char* lds, const Gemm g, const Sched S, const Epi E, int tid_in) {
    int tid_ = tid_in; asm volatile("" : "+v"(tid_));
    const int tid = tid_, wid = __builtin_amdgcn_readfirstlane(tid >> 6), lane = tid & 63, wr = wid >> 2, wc = wid & 3, fr = lane & 15, fq = lane >> 4;
    const int K = g.K, nt = K / BK;
    unsigned voffA[2], voffB[2];
#pragma unroll
    for (int i = 0; i < 2; ++i) { int R, C; stage_rc(tid * 16 + i * 8192, R, C); const int Rb = Epi::PERM ? ((R & ~31) + perm32(R & 31)) : R;
        voffA[i] = (unsigned)(R * K + C) * 2u; voffB[i] = (unsigned)(Rb * K + C) * 2u; }
    const size_t kstep = (size_t)(BK * 2);
    const size_t hstep = (size_t)HALF * K * 2;
    const size_t tstep = 2 * hstep;
    const unsigned ldsw = (unsigned)wid * 1024u;
    const int aoff = lds_byte(wr * 64 + fr, fq * 8), boff = lds_byte(wc * 32 + fr, fq * 8);
#define PG8_SA(b, h) (((b) * 2 + (h)) * HTB)
#define PG8_SB(b, h) ((4 + (b) * 2 + (h)) * HTB)
#define PG8_STAGE(bufoff, gbase, voff) do { _Pragma("unroll") for (int _i = 0; _i < 2; ++_i) \
        __builtin_amdgcn_global_load_lds((const unsigned*)((const char*)(gbase) + (voff)[_i]), (PG8_LAS unsigned*)(lds + (bufoff) + ldsw + _i * 8192), 16, 0, 0); } while (0)
#define PG8_LDA(dst, b, h) do { _Pragma("unroll") for (int m = 0; m < 4; ++m) _Pragma("unroll") for (int k = 0; k < 2; ++k) dst[m][k] = *(const PG8_LAS bf16x8*)(lds + PG8_SA(b, h) + aoff + m * 2048 + k * 1024); } while (0)
#define PG8_LDB(dst, b, h) do { _Pragma("unroll") for (int n = 0; n < 2; ++n) _Pragma("unroll") for (int k = 0; k < 2; ++k) dst[n][k] = *(const PG8_LAS bf16x8*)(lds + PG8_SB(b, h) + boff + n * 2048 + k * 1024); } while (0)
#define PG8_MMA(ai, bj, At, Bt) do { __builtin_amdgcn_s_setprio(1); _Pragma("unroll") for (int m = 0; m < 4; ++m) _Pragma("unroll") for (int n = 0; n < 2; ++n) _Pragma("unroll") for (int k = 0; k < 2; ++k) \
        acc[ai][bj][m][n] = __builtin_amdgcn_mfma_f32_16x16x32_bf16(Bt[n][k], At[m][k], acc[ai][bj][m][n], 0, 0, 0); __builtin_amdgcn_s_setprio(0); } while (0)
#define PG8_WAIT_V(n) asm volatile("s_waitcnt vmcnt(" #n ")" ::: "memory")
#define PG8_WAIT_L(n) asm volatile("s_waitcnt lgkmcnt(" #n ")" ::: "memory")
#define PG8_BAR __builtin_amdgcn_s_barrier()
#define PG8_SCHED __builtin_amdgcn_sched_barrier(0)
    Unit cur, nxt; int ui = 0;
    if (!S.next(0, cur)) return;
    f32x4 acc[2][2][4][2];
#pragma unroll
    for (int a = 0; a < 2; ++a)
#pragma unroll
        for (int b = 0; b < 2; ++b)
#pragma unroll
            for (int m = 0; m < 4; ++m)
#pragma unroll
                for (int n = 0; n < 2; ++n) acc[a][b][m][n] = (f32x4){0.f, 0.f, 0.f, 0.f};
    bf16x8 At[4][2], B0[2][2], B1[2][2];
    const char* cA = (const char*)g.A + (size_t)cur.pm * tstep; const char* cB = (const char*)g.Bt + (size_t)cur.pn * tstep;
    S.a_ready(cur);
    if constexpr (SP2) {
        PG8_STAGE(PG8_SB(0, 0), cB, voffB); PG8_STAGE(PG8_SB(0, 1), cB + hstep, voffB); PG8_STAGE(PG8_SA(0, 0), cA, voffA); PG8_STAGE(PG8_SA(0, 1), cA + hstep, voffA);
        if (wr == 1) PG8_BAR;
        PG8_WAIT_V(2); PG8_BAR;
        PG8_STAGE(PG8_SB(1, 0), cB + kstep, voffB); PG8_STAGE(PG8_SA(1, 0), cA + kstep, voffA); PG8_STAGE(PG8_SB(1, 1), cB + hstep + kstep, voffB);
        PG8_WAIT_V(6); PG8_BAR;
    } else {
        PG8_STAGE(PG8_SB(0, 0), cB, voffB); PG8_STAGE(PG8_SA(0, 0), cA, voffA); PG8_STAGE(PG8_SB(0, 1), cB + hstep, voffB); PG8_STAGE(PG8_SA(0, 1), cA + hstep, voffA);
        if (wr == 1) PG8_BAR;
        PG8_WAIT_V(4); PG8_BAR;
        PG8_STAGE(PG8_SB(1, 0), cB + kstep, voffB); PG8_STAGE(PG8_SA(1, 0), cA + kstep, voffA); PG8_STAGE(PG8_SB(1, 1), cB + hstep + kstep, voffB);
        PG8_WAIT_V(6); PG8_BAR;
    }
    for (;;) {
        const bool has_next = S.next(ui + 1, nxt);
        const char* nA = has_next ? (const char*)g.A + (size_t)nxt.pm * tstep : cA; const char* nB = has_next ? (const char*)g.Bt + (size_t)nxt.pn * tstep : cB;
        for (int t = 0; t < nt; t += 2) {
            const bool last = (t == nt - 2);
            const char* a1 = cA + (size_t)(t + 1) * kstep;
            const char* a2 = last ? nA : cA + (size_t)(t + 2) * kstep; const char* b2 = last ? nB : cB + (size_t)(t + 2) * kstep;
            const char* a3 = a2 + kstep; const char* b3 = b2 + kstep;
            if (last && has_next) S.a_ready(nxt);
            if constexpr (SP2) {
            PG8_LDB(B0, 0, 0); PG8_LDB(B1, 0, 1); PG8_SCHED; PG8_LDA(At, 0, 0); PG8_STAGE(PG8_SA(1, 1), a1 + hstep, voffA);
            PG8_WAIT_V(8); PG8_WAIT_L(0); PG8_BAR; PG8_MMA(0, 0, At, B0); PG8_MMA(0, 1, At, B1); PG8_BAR; PG8_SCHED;
            PG8_LDA(At, 0, 1); PG8_STAGE(PG8_SB(0, 0), b2, voffB); PG8_STAGE(PG8_SB(0, 1), b2 + hstep, voffB); PG8_STAGE(PG8_SA(0, 0), a2, voffA);
            PG8_WAIT_V(8); PG8_WAIT_L(0); PG8_BAR; PG8_MMA(1, 0, At, B0); PG8_MMA(1, 1, At, B1); PG8_BAR; PG8_SCHED;
            PG8_LDB(B0, 1, 0); PG8_LDB(B1, 1, 1); PG8_SCHED; PG8_LDA(At, 1, 0); PG8_STAGE(PG8_SA(0, 1), a2 + hstep, voffA);
            PG8_WAIT_V(8); PG8_WAIT_L(0); PG8_BAR; PG8_MMA(0, 0, At, B0); PG8_MMA(0, 1, At, B1); PG8_BAR; PG8_SCHED;
            PG8_LDA(At, 1, 1); PG8_STAGE(PG8_SB(1, 0), b3, voffB); PG8_STAGE(PG8_SB(1, 1), b3 + hstep, voffB); PG8_STAGE(PG8_SA(1, 0), a3, voffA);
            PG8_WAIT_V(8); PG8_WAIT_L(0); PG8_BAR; PG8_MMA(1, 0, At, B0); PG8_MMA(1, 1, At, B1); PG8_BAR; PG8_SCHED;
            } else {
            PG8_LDB(B0, 0, 0); PG8_SCHED; PG8_LDA(At, 0, 0); PG8_STAGE(PG8_SA(1, 1), a1 + hstep, voffA);
            PG8_WAIT_L(8); PG8_BAR; PG8_WAIT_L(0); PG8_MMA(0, 0, At, B0); PG8_BAR; PG8_SCHED;
            PG8_LDB(B1, 0, 1); PG8_STAGE(PG8_SB(0, 0), b2, voffB);
            PG8_BAR; PG8_WAIT_L(0); PG8_MMA(0, 1, At, B1); PG8_BAR;
            PG8_LDA(At, 0, 1); PG8_STAGE(PG8_SA(0, 0), a2, voffA);
            PG8_BAR; PG8_WAIT_L(0); PG8_MMA(1, 0, At, B0); PG8_BAR; PG8_SCHED;
            PG8_STAGE(PG8_SB(0, 1), b2 + hstep, voffB);
            PG8_WAIT_V(6); PG8_BAR; PG8_MMA(1, 1, At, B1); PG8_BAR;
            PG8_LDB(B0, 1, 0); PG8_SCHED; PG8_LDA(At, 1, 0); PG8_STAGE(PG8_SA(0, 1), a2 + hstep, voffA);
            PG8_WAIT_L(8); PG8_BAR; PG8_WAIT_L(0); PG8_MMA(0, 0, At, B0); PG8_BAR; PG8_SCHED;
            PG8_LDB(B1, 1, 1); PG8_STAGE(PG8_SB(1, 0), b3, voffB);
            PG8_BAR; PG8_WAIT_L(0); PG8_MMA(0, 1, At, B1); PG8_BAR;
            PG8_LDA(At, 1, 1); PG8_STAGE(PG8_SA(1, 0), a3, voffA);
            PG8_BAR; PG8_WAIT_L(0); PG8_MMA(1, 0, At, B0); PG8_BAR; PG8_SCHED;
            PG8_STAGE(PG8_SB(1, 1), b3 + hstep, voffB);
            PG8_WAIT_V(6); PG8_BAR; PG8_MMA(1, 1, At, B1); PG8_BAR;
            }
        }
        if constexpr (ALIGN_EPI) { if (wr == 0) PG8_BAR; }
        if constexpr (!Epi::AFTER_DRAIN) { E(acc, cur, wr, wc, fr, fq); S.done(cur); }
        if (!has_next) break;
#pragma unroll
        for (int a = 0; a < 2; ++a)
#pragma unroll
            for (int b = 0; b < 2; ++b)
#pragma unroll
                for (int m = 0; m < 4; ++m)
#pragma unroll
                    for (int n = 0; n < 2; ++n) acc[a][b][m][n] = (f32x4){0.f, 0.f, 0.f, 0.f};
        cur = nxt; cA = nA; cB = nB; ++ui;
        if constexpr (ALIGN_EPI) { if (wr == 1) PG8_BAR; }
    }
    PG8_WAIT_V(0);
    if constexpr (!ALIGN_EPI) { if (wr == 0) PG8_BAR; }
    PG8_BAR;
    if constexpr (Epi::AFTER_DRAIN) { E.fused(acc, cur, wr, wc, fr, fq, lds, wid, lane); S.done(cur); }
#undef PG8_SA
#undef PG8_SB
#undef PG8_STAGE
#undef PG8_LDA
#undef PG8_LDB
#undef PG8_MMA
#undef PG8_WAIT_V
#undef PG8_WAIT_L
#undef PG8_BAR
#undef PG8_SCHED
}
}
using pg8::bf16_t; using pg8::f32x4; using pg8::u32x4; using pg8::Unit; using pg8::cvt_pk_bf16;
#define LAS __attribute__((address_space(3)))
#define DI __device__ __forceinline__
#define LDS_WAIT() asm volatile("s_waitcnt lgkmcnt(0)" ::: "memory")
typedef float f32x2 __attribute__((ext_vector_type(2)));
typedef unsigned u32x2 __attribute__((ext_vector_type(2)));

constexpr int D = 1024, MP = 4096, MS = 8192, M = 12288, MALL = 16384;
constexpr int DFF = 2816, NGU = 5632;
constexpr float EPS = 1e-6f;
constexpr float LOG2E = 1.4426950408889634f;
constexpr float QSCALE64 = 0.125f * LOG2E;
constexpr float QSCALE96 = 0.10206207261596575f * LOG2E;
constexpr int NWAVES = 8, NTHR = 512;
constexpr int RING_BYTES = 131072, LDS_BYTES = 147456;

constexpr size_t SZ_WGU = (size_t)NGU * D * 2, SZ_WDN = (size_t)D * DFF * 2;
constexpr size_t O_WGU = 0;
constexpr size_t O_WDN = O_WGU + 8 * SZ_WGU;
constexpr size_t O_WAQKV = O_WDN + 8 * SZ_WDN;
constexpr size_t O_WAO = O_WAQKV + 1536ull * 1024 * 2;
constexpr size_t O_WBQKV = O_WAO + 1024ull * 1024 * 2;
constexpr size_t O_WBO = O_WBQKV + 1536ull * 1024 * 2;
constexpr size_t O_WCDN = O_WBO + 1024ull * 1024 * 2;
constexpr size_t O_WCUQ = O_WCDN + 768ull * 1024 * 2;
constexpr size_t O_WCUKV = O_WCUQ + 1536ull * 384 * 2;
constexpr size_t O_WCO = O_WCUKV + 2048ull * 256 * 2;
constexpr size_t O_WDQKV = O_WCO + 1024ull * 1024 * 2;
constexpr size_t O_WDO = O_WDQKV + 3072ull * 1024 * 2;
constexpr size_t O_XS = O_WDO + 1024ull * 1024 * 2;
constexpr size_t O_ACT = O_XS + (size_t)M * D * 2;
constexpr size_t O_Q = O_ACT + (size_t)M * DFF * 2;
constexpr size_t O_K = O_Q + (size_t)M * 1536 * 2;
constexpr size_t O_V = O_K + (size_t)MALL * 1536 * 2;
constexpr size_t O_OB = O_V + (size_t)MALL * 1024 * 2;
constexpr size_t O_CQS = O_OB + (size_t)M * D * 2;
constexpr size_t O_CKVS = O_CQS + (size_t)M * 384 * 2;
constexpr size_t O_KR = O_CKVS + (size_t)MALL * 256 * 2;
constexpr size_t O_CACHE = O_KR + (size_t)M * 32 * 4;
constexpr size_t O_STATS = O_CACHE + (4ull * 1048576 + 2ull * 4194304) * 2;
constexpr size_t O_CSTATS = O_STATS + (size_t)M * 16 * 4;
constexpr size_t O_MODP = O_CSTATS + (size_t)M * 24 * 4;
constexpr size_t O_MOD = O_MODP + 4ull * 8 * 9 * 9216 * 4;
constexpr size_t O_GS = O_MOD + 4ull * 9 * 9216 * 4;
constexpr size_t O_SHA = O_GS + 4ull * 3 * 9 * 1024 * 4;
constexpr size_t O_BIAS = O_SHA + 12ull * 256 * 1024 * 2;
constexpr size_t O_CSHD = O_BIAS + 12ull * 9 * NGU * 4;
constexpr size_t O_CSC = O_CSHD + 1024ull * 32 * 8;
constexpr size_t O_CTL = O_CSC + 1024ull * 16 * 8;
constexpr size_t WS_NEED = O_CTL + 262144;

constexpr size_t OUT_AK = 12582912, OUT_AV = 13631488, OUT_BK = 14680064, OUT_BV = 15728640, OUT_CKV = 16777216, OUT_CKR = 17825792, OUT_DK = 17956864, OUT_DV = 22151168;

struct Args { const float* in[43]; float* out; unsigned char* ws; int ph_lo, ph_hi; };

DI float bf2f(unsigned short u) { return __builtin_bit_cast(float, (unsigned)u << 16); }
DI float bflo(unsigned w) { return __builtin_bit_cast(float, w << 16); }
DI float bfhi(unsigned w) { return __builtin_bit_cast(float, w & 0xffff0000u); }
DI int mrow_of_tile(int pm) { return pm < 16 ? 0 : 1 + ((pm - 16) >> 2); }
DI float wave_sum(float v) {
#pragma unroll
    for (int o = 1; o < 64; o <<= 1) v += __shfl_xor(v, o);
    return v;
}
DI float sum4(f32x4 a) { return (a.x + a.y) + (a.z + a.w); }
DI float sq4(f32x4 a) { return (a.x * a.x + a.y * a.y) + (a.z * a.z + a.w * a.w); }
DI float row_rs(const float* stats, int row) {
    const f32x4* s = (const f32x4*)(stats + (size_t)row * 16);
    const float t = (sum4(s[0]) + sum4(s[1])) + (sum4(s[2]) + sum4(s[3]));
    return rsqrtf(t * (1.f / 1024.f) + EPS);
}
#define GAS __attribute__((address_space(1)))
DI void row_rs8(const float* stats, int row0, int fq, float (&rr)[2][4]) {
    f32x4 p[2][4];
#pragma unroll
    for (int ai = 0; ai < 2; ++ai)
#pragma unroll
        for (int m = 0; m < 4; ++m) p[ai][m] = *(const GAS f32x4*)(stats + (size_t)(row0 + ai * 128 + m * 16) * 16 + 4 * fq);
#pragma unroll
    for (int ai = 0; ai < 2; ++ai)
#pragma unroll
        for (int m = 0; m < 4; ++m) { float t = sum4(p[ai][m]); t += __shfl_xor(t, 16); t += __shfl_xor(t, 32); rr[ai][m] = rsqrtf(t * (1.f / 1024.f) + EPS); }
}
DI float silu_f(float a) { return a * __builtin_amdgcn_rcpf(1.f + __builtin_amdgcn_exp2f(-a * LOG2E)); }
DI u32x4 pack8(f32x4 a, f32x4 b) { u32x4 w; w.x = cvt_pk_bf16(a.x, a.y); w.y = cvt_pk_bf16(a.z, a.w); w.z = cvt_pk_bf16(b.x, b.y); w.w = cvt_pk_bf16(b.z, b.w); return w; }

struct EpiBias {
    static constexpr bool PERM = true, AFTER_DRAIN = false;
    float* bias;
    DI void operator()(const f32x4 (&acc)[2][2][4][2], const Unit& u, int wr, int wc, int fr, int fq) const {
        int pm_ = u.pm, pn_ = u.pn; asm volatile("" : "+s"(pm_), "+s"(pn_), "+s"(wr), "+s"(wc)); asm volatile("" : "+v"(fr), "+v"(fq));
        if (wr == 0 && fr < 9) {
#pragma unroll
            for (int bj = 0; bj < 2; ++bj) { float* p = bias + (size_t)fr * NGU + pn_ * 256 + bj * 128 + wc * 32 + 8 * fq;
                *(f32x4*)p = acc[0][bj][0][0]; *(f32x4*)(p + 4) = acc[0][bj][0][1]; }
        }
    }
};
struct EpiGU {
    static constexpr bool PERM = true, AFTER_DRAIN = false;
    const float* stats; const float* bias; bf16_t* act;
    DI void operator()(const f32x4 (&acc)[2][2][4][2], const Unit& u, int wr, int wc, int fr, int fq) const {
        int pm_ = u.pm, pn_ = u.pn; asm volatile("" : "+s"(pm_), "+s"(pn_), "+s"(wr), "+s"(wc)); asm volatile("" : "+v"(fr), "+v"(fq));
        const int mr = mrow_of_tile(pm_);
        const float* bp = bias + (size_t)mr * NGU + pn_ * 256 + wc * 32 + 8 * fq;
        const f32x4 ba0 = *(const GAS f32x4*)bp, ba1 = *(const GAS f32x4*)(bp + 4), bu0 = *(const GAS f32x4*)(bp + 128), bu1 = *(const GAS f32x4*)(bp + 132);
        float rr8[2][4]; row_rs8(stats, pm_ * 256 + wr * 64 + fr, fq, rr8);
#pragma unroll
        for (int ai = 0; ai < 2; ++ai)
#pragma unroll
            for (int m = 0; m < 4; ++m) {
                __builtin_amdgcn_sched_barrier(0);
                const int row = pm_ * 256 + ai * 128 + wr * 64 + m * 16 + fr;
                const float rr = rr8[ai][m];
                const f32x4 a0 = acc[ai][0][m][0] * rr + ba0, a1 = acc[ai][0][m][1] * rr + ba1, u0 = acc[ai][1][m][0] * rr + bu0, u1 = acc[ai][1][m][1] * rr + bu1;
                f32x4 r0, r1;
#pragma unroll
                for (int j = 0; j < 4; ++j) { r0[j] = silu_f(a0[j]) * u0[j]; r1[j] = silu_f(a1[j]) * u1[j]; }
                *(GAS u32x4*)(act + (size_t)row * DFF + pn_ * 128 + wc * 32 + 8 * fq) = pack8(r0, r1);
            }
    }
};
struct EpiRes {
    static constexpr bool PERM = true, AFTER_DRAIN = false;
    float* X; const float* gate; const float* gsn; bf16_t* xs; float* stats; const float* Xr0; const float* Xr1; float gscale; float pad_;
    DI void operator()(const f32x4 (&acc)[2][2][4][2], const Unit& u, int wr, int wc, int fr, int fq) const {
        int pm_ = u.pm, pn_ = u.pn; asm volatile("" : "+s"(pm_), "+s"(pn_), "+s"(wr), "+s"(wc)); asm volatile("" : "+v"(fr), "+v"(fq));
        const int mr = mrow_of_tile(pm_);
        const int c0 = pn_ * 256 + wc * 32 + 8 * fq;
        f32x4 g[2][2], s[2][2];
#pragma unroll
        for (int bj = 0; bj < 2; ++bj) { const float* gp = gate + (size_t)mr * 9216 + c0 + bj * 128; g[bj][0] = *(const f32x4*)gp * gscale; g[bj][1] = *(const f32x4*)(gp + 4) * gscale;
            if (gsn) { const float* sp = gsn + (size_t)mr * 1024 + c0 + bj * 128; s[bj][0] = *(const f32x4*)sp; s[bj][1] = *(const f32x4*)(sp + 4); } else { s[bj][0] = s[bj][1] = (f32x4){0.f, 0.f, 0.f, 0.f}; } }
        f32x4 xc[2][2], xn[2][2];
#define RES_LOAD(DST, I) do { const int row_ = pm_ * 256 + ((I) >> 2) * 128 + wr * 64 + ((I) & 3) * 16 + fr; const float* xb_ = (row_ < MP ? Xr0 : Xr1) + (size_t)row_ * D + c0; \
            _Pragma("unroll") for (int bj = 0; bj < 2; ++bj) { DST[bj][0] = *(const GAS f32x4*)(xb_ + bj * 128); DST[bj][1] = *(const GAS f32x4*)(xb_ + bj * 128 + 4); } } while (0)
        RES_LOAD(xc, 0);
#pragma unroll
        for (int i = 0; i < 8; ++i) {
            const int ai = i >> 2, m = i & 3;
            if (i < 7) RES_LOAD(xn, i + 1);
            const int row = pm_ * 256 + ai * 128 + wr * 64 + m * 16 + fr;
            float ss = 0.f;
#pragma unroll
            for (int bj = 0; bj < 2; ++bj) {
                float* xp = X + (size_t)row * D + c0 + bj * 128;
                f32x4 x0 = xc[bj][0], x1 = xc[bj][1];
                x0 += g[bj][0] * acc[ai][bj][m][0]; x1 += g[bj][1] * acc[ai][bj][m][1];
                *(GAS f32x4*)xp = x0; *(GAS f32x4*)(xp + 4) = x1;
                ss += sq4(x0) + sq4(x1);
                if (gsn) *(GAS u32x4*)(xs + (size_t)row * D + c0 + bj * 128) = pack8(x0 * s[bj][0], x1 * s[bj][1]);
            }
            ss += __shfl_xor(ss, 16); ss += __shfl_xor(ss, 32);
            if (gsn && fq == 0) *(GAS float*)(stats + (size_t)row * 16 + pn_ * 4 + wc) = ss;
#pragma unroll
            for (int bj = 0; bj < 2; ++bj) { xc[bj][0] = xn[bj][0]; xc[bj][1] = xn[bj][1]; }
        }
#undef RES_LOAD
    }
};
struct EpiQKV {
    static constexpr bool PERM = true, AFTER_DRAIN = false;
    const float* stats; const float* bias; int nkv; int rope; const float* qg; const float* kg; const float* cs;
    bf16_t* q; bf16_t* k; bf16_t* v; float* ok; float* ov;
    DI void operator()(const f32x4 (&acc)[2][2][4][2], const Unit& u, int wr, int wc, int fr, int fq) const {
        int pm_ = u.pm, pn_ = u.pn; asm volatile("" : "+s"(pm_), "+s"(pn_), "+s"(wr), "+s"(wc)); asm volatile("" : "+v"(fr), "+v"(fq));
        const int mr = mrow_of_tile(pm_);
        const int slot = 4 * pn_ + wc;
        const int type = slot < 16 ? 0 : (slot < 16 + nkv ? 1 : 2);
        const int hh = type == 0 ? slot : (type == 1 ? slot - 16 : slot - 16 - nkv);
        const int kvw = nkv * 64;
        f32x4 b[2][2], gn[2][2];
#pragma unroll
        for (int bj = 0; bj < 2; ++bj) { const float* bp = bias + (size_t)mr * NGU + pn_ * 256 + bj * 128 + wc * 32 + 8 * fq; b[bj][0] = *(const f32x4*)bp; b[bj][1] = *(const f32x4*)(bp + 4);
            const float* gp = (type == 0 ? qg : kg) + 32 * bj + 8 * fq; gn[bj][0] = *(const f32x4*)gp; gn[bj][1] = *(const f32x4*)(gp + 4); }
        float rr8[2][4]; row_rs8(stats, pm_ * 256 + wr * 64 + fr, fq, rr8);
#pragma unroll
        for (int ai = 0; ai < 2; ++ai)
#pragma unroll
            for (int m = 0; m < 4; ++m) {
                __builtin_amdgcn_sched_barrier(0);
                const int row = pm_ * 256 + ai * 128 + wr * 64 + m * 16 + fr;
                const float rr = rr8[ai][m];
                f32x4 v0[2], v1[2];
#pragma unroll
                for (int bj = 0; bj < 2; ++bj) { v0[bj] = acc[ai][bj][m][0] * rr + b[bj][0]; v1[bj] = acc[ai][bj][m][1] * rr + b[bj][1]; }
                if (type < 2) {
                    float ss = (sq4(v0[0]) + sq4(v1[0])) + (sq4(v0[1]) + sq4(v1[1]));
                    ss += __shfl_xor(ss, 16); ss += __shfl_xor(ss, 32);
                    const float rinv = rsqrtf(ss * (1.f / 64.f) + EPS);
#pragma unroll
                    for (int bj = 0; bj < 2; ++bj) { v0[bj] = v0[bj] * rinv * gn[bj][0]; v1[bj] = v1[bj] * rinv * gn[bj][1]; }
                    if (type == 1 && row < MP) {
#pragma unroll
                        for (int bj = 0; bj < 2; ++bj) { float* op = ok + (size_t)row * kvw + hh * 64 + 32 * bj + 8 * fq; *(f32x4*)op = v0[bj]; *(f32x4*)(op + 4) = v1[bj]; }
                    }
                    if (rope && row >= MP) {
                        const int pos = (row - MP) & 1023;
#pragma unroll
                        for (int bj = 0; bj < 2; ++bj) {
                            const float* cp = cs + ((size_t)pos * 32 + 16 * bj + 4 * fq) * 2;
                            const f32x4 t0 = *(const f32x4*)cp, t1 = *(const f32x4*)(cp + 4);
                            f32x4 a = v0[bj], c = v1[bj];
                            v0[bj] = (f32x4){a.x * t0.x - a.y * t0.y, a.x * t0.y + a.y * t0.x, a.z * t0.z - a.w * t0.w, a.z * t0.w + a.w * t0.z};
                            v1[bj] = (f32x4){c.x * t1.x - c.y * t1.y, c.x * t1.y + c.y * t1.x, c.z * t1.z - c.w * t1.w, c.z * t1.w + c.w * t1.z};
                        }
                    }
                    if (type == 0) {
#pragma unroll
                        for (int bj = 0; bj < 2; ++bj) *(u32x4*)(q + (size_t)row * 1024 + hh * 64 + 32 * bj + 8 * fq) = pack8(v0[bj] * QSCALE64, v1[bj] * QSCALE64);
                    } else {
#pragma unroll
                        for (int bj = 0; bj < 2; ++bj) *(u32x4*)(k + (size_t)row * kvw + hh * 64 + 32 * bj + 8 * fq) = pack8(v0[bj], v1[bj]);
                    }
                } else {
#pragma unroll
                    for (int bj = 0; bj < 2; ++bj) { *(u32x4*)(v + (size_t)row * kvw + hh * 64 + 32 * bj + 8 * fq) = pack8(v0[bj], v1[bj]);
                        if (row < MP) { float* op = ov + (size_t)row * kvw + hh * 64 + 32 * bj + 8 * fq; *(f32x4*)op = v0[bj]; *(f32x4*)(op + 4) = v1[bj]; } }
                }
            }
    }
};
struct EpiCDown {
    static constexpr bool PERM = true, AFTER_DRAIN = false;
    const float* stats; const float* bias; const float* qln; const float* kvln; bf16_t* cqs; bf16_t* ckvs; float* krb; float* cst; float* okv; float* okr;
    DI void operator()(const f32x4 (&acc)[2][2][4][2], const Unit& u, int wr, int wc, int fr, int fq) const {
        int pm_ = u.pm, pn_ = u.pn; asm volatile("" : "+s"(pm_), "+s"(pn_), "+s"(wr), "+s"(wc)); asm volatile("" : "+v"(fr), "+v"(fq));
        const int mr = mrow_of_tile(pm_);
        float rr8[2][4]; row_rs8(stats, pm_ * 256 + wr * 64 + fr, fq, rr8);
#pragma unroll
        for (int bj = 0; bj < 2; ++bj) {
            const int c0 = pn_ * 256 + bj * 128 + wc * 32 + 8 * fq;
            if (c0 >= 672) continue;
            const float* bp = bias + (size_t)mr * NGU + c0;
            const f32x4 b0 = *(const f32x4*)bp, b1 = *(const f32x4*)(bp + 4);
            const int reg = c0 < 384 ? 0 : (c0 < 640 ? 1 : 2);
            f32x4 g0 = (f32x4){1.f, 1.f, 1.f, 1.f}, g1 = g0;
            if (reg == 0) { g0 = *(const f32x4*)(qln + c0); g1 = *(const f32x4*)(qln + c0 + 4); }
            if (reg == 1) { g0 = *(const f32x4*)(kvln + c0 - 384); g1 = *(const f32x4*)(kvln + c0 - 380); }
#pragma unroll
            for (int ai = 0; ai < 2; ++ai)
#pragma unroll
                for (int m = 0; m < 4; ++m) {
                    __builtin_amdgcn_sched_barrier(0);
                const int row = pm_ * 256 + ai * 128 + wr * 64 + m * 16 + fr;
                    const float rr = rr8[ai][m];
                    const f32x4 v0 = acc[ai][bj][m][0] * rr + b0, v1 = acc[ai][bj][m][1] * rr + b1;
                    float ss = sq4(v0) + sq4(v1);
                    ss += __shfl_xor(ss, 16); ss += __shfl_xor(ss, 32);
                    if (fq == 0) cst[(size_t)row * 24 + pn_ * 8 + bj * 4 + wc] = ss;
                    if (reg == 0) *(u32x4*)(cqs + (size_t)row * 384 + c0) = pack8(v0 * g0, v1 * g1);
                    else if (reg == 1) { const f32x4 w0 = v0 * g0, w1 = v1 * g1; *(u32x4*)(ckvs + (size_t)row * 256 + c0 - 384) = pack8(w0, w1);
                        if (row < MP) { float* op = okv + (size_t)row * 256 + c0 - 384; *(f32x4*)op = w0; *(f32x4*)(op + 4) = w1; } }
                    else { float* kp = krb + (size_t)row * 32 + c0 - 640; *(f32x4*)kp = v0; *(f32x4*)(kp + 4) = v1;
                        if (row < MP) { float* op = okr + (size_t)row * 32 + c0 - 640; *(f32x4*)op = v0; *(f32x4*)(op + 4) = v1; } }
                }
        }
    }
};
DI float cst_sum(const float* cst, int row, int lo, int cnt4) {
    const f32x4* s = (const f32x4*)(cst + (size_t)row * 24 + lo); float t = 0.f;
    for (int i = 0; i < cnt4; ++i) t += sum4(s[i]);
    return t;
}
struct EpiUQ {
    static constexpr bool PERM = true, AFTER_DRAIN = false;
    const float* cst; bf16_t* qraw;
    DI void operator()(const f32x4 (&acc)[2][2][4][2], const Unit& u, int wr, int wc, int fr, int fq) const {
        int pm_ = u.pm, pn_ = u.pn; asm volatile("" : "+s"(pm_), "+s"(pn_), "+s"(wr), "+s"(wc)); asm volatile("" : "+v"(fr), "+v"(fq));
#pragma unroll
        for (int ai = 0; ai < 2; ++ai)
#pragma unroll
            for (int m = 0; m < 4; ++m) {
                __builtin_amdgcn_sched_barrier(0);
                const int row = pm_ * 256 + ai * 128 + wr * 64 + m * 16 + fr;
                const float rq = rsqrtf(cst_sum(cst, row, 0, 3) * (1.f / 384.f) + EPS);
#pragma unroll
                for (int bj = 0; bj < 2; ++bj) *(u32x4*)(qraw + (size_t)row * 1536 + pn_ * 256 + bj * 128 + wc * 32 + 8 * fq) = pack8(acc[ai][bj][m][0] * rq, acc[ai][bj][m][1] * rq);
            }
    }
};
struct EpiUKV {
    static constexpr bool PERM = true, AFTER_DRAIN = false;
    const float* cst; const float* krb; const float* krc; const float* kg; const float* cs; bf16_t* kk; bf16_t* vv;
    DI void operator()(const f32x4 (&acc)[2][2][4][2], const Unit& u, int wr, int wc, int fr, int fq) const {
        int pm_ = u.pm, pn_ = u.pn; asm volatile("" : "+s"(pm_), "+s"(pn_), "+s"(wr), "+s"(wc)); asm volatile("" : "+v"(fr), "+v"(fq));
        const int slot = 4 * pn_ + wc, h = slot >> 1, part = slot & 1;
        f32x4 gn[2][2], gr0, gr1;
#pragma unroll
        for (int bj = 0; bj < 2; ++bj) { gn[bj][0] = *(const f32x4*)(kg + 32 * bj + 8 * fq); gn[bj][1] = *(const f32x4*)(kg + 32 * bj + 8 * fq + 4); }
        gr0 = *(const f32x4*)(kg + 64 + 8 * fq); gr1 = *(const f32x4*)(kg + 68 + 8 * fq);
#pragma unroll
        for (int ai = 0; ai < 2; ++ai)
#pragma unroll
            for (int m = 0; m < 4; ++m) {
                __builtin_amdgcn_sched_barrier(0);
                const int row = pm_ * 256 + ai * 128 + wr * 64 + m * 16 + fr;
                const float rkv = row < M ? rsqrtf(cst_sum(cst, row, 12, 2) * (1.f / 256.f) + EPS) : 1.f;
                f32x4 v0[2], v1[2];
#pragma unroll
                for (int bj = 0; bj < 2; ++bj) { v0[bj] = acc[ai][bj][m][0] * rkv; v1[bj] = acc[ai][bj][m][1] * rkv; }
                if (part == 1) {
#pragma unroll
                    for (int bj = 0; bj < 2; ++bj) *(u32x4*)(vv + (size_t)row * 1024 + h * 64 + 32 * bj + 8 * fq) = pack8(v0[bj], v1[bj]);
                } else {
                    const float* kp = (row < M ? krb + (size_t)row * 32 : krc + (size_t)(row - M) * 32) + 8 * fq;
                    f32x4 k0 = *(const f32x4*)kp, k1 = *(const f32x4*)(kp + 4);
                    float ss = (sq4(v0[0]) + sq4(v1[0])) + (sq4(v0[1]) + sq4(v1[1])) + (sq4(k0) + sq4(k1));
                    ss += __shfl_xor(ss, 16); ss += __shfl_xor(ss, 32);
                    const float rk = rsqrtf(ss * (1.f / 96.f) + EPS);
#pragma unroll
                    for (int bj = 0; bj < 2; ++bj) *(u32x4*)(kk + (size_t)row * 1536 + h * 96 + 32 * bj + 8 * fq) = pack8(v0[bj] * rk * gn[bj][0], v1[bj] * rk * gn[bj][1]);
                    k0 = k0 * rk * gr0; k1 = k1 * rk * gr1;
                    if (row >= MP && row < M) {
                        const int pos = (row - MP) & 1023;
                        const float* cp = cs + ((size_t)pos * 16 + 4 * fq) * 2;
                        const f32x4 t0 = *(const f32x4*)cp, t1 = *(const f32x4*)(cp + 4);
                        const f32x4 a = k0, c = k1;
                        k0 = (f32x4){a.x * t0.x - a.y * t0.y, a.x * t0.y + a.y * t0.x, a.z * t0.z - a.w * t0.w, a.z * t0.w + a.w * t0.z};
                        k1 = (f32x4){c.x * t1.x - c.y * t1.y, c.x * t1.y + c.y * t1.x, c.z * t1.z - c.w * t1.w, c.z * t1.w + c.w * t1.z};
                    }
                    *(u32x4*)(kk + (size_t)row * 1536 + h * 96 + 64 + 8 * fq) = pack8(k0, k1);
                }
            }
    }
};
DI void transpose_item(const float* W, int K, int N, bf16_t* WT, int perm, int item, int lane) {
    const int nblk = N / 32, kb = item / nblk, nb = item % nblk, k0 = 64 * kb, n0 = 32 * nb;
    const int kg = lane >> 3, ng = lane & 7;
    const float* src = W + (size_t)(k0 + 8 * kg) * N + n0 + 4 * ng;
    f32x4 v[8];
#pragma unroll
    for (int kk = 0; kk < 8; ++kk) v[kk] = *(const f32x4*)(src + (size_t)kk * N);
    int r0 = n0;
    if (perm == 1) { const int j = n0 < DFF ? n0 : n0 - DFF; r0 = 256 * (j >> 7) + (n0 < DFF ? 0 : 128) + (j & 127); }
    else if (perm == 2) { const int slot = n0 >> 6, d = n0 & 63; r0 = 256 * (slot >> 2) + 128 * (d >> 5) + 32 * (slot & 3); }
    bf16_t* dst = WT + (size_t)(r0 + 4 * ng) * K + k0 + 8 * kg;
#pragma unroll
    for (int j = 0; j < 4; ++j) { u32x4 o; o.x = cvt_pk_bf16(v[0][j], v[1][j]); o.y = cvt_pk_bf16(v[2][j], v[3][j]); o.z = cvt_pk_bf16(v[4][j], v[5][j]); o.w = cvt_pk_bf16(v[6][j], v[7][j]);
        *(u32x4*)(dst + (size_t)j * K) = o; }
}
DI void cvt_range(const float* src, bf16_t* dst, size_t n8, size_t gt, size_t ngt) {
    for (size_t i = gt; i < n8; i += ngt) { const f32x4 a = *(const f32x4*)(src + i * 8), b = *(const f32x4*)(src + i * 8 + 4); *(u32x4*)(dst + i * 8) = pack8(a, b); }
}
DI float modval(const float* modp, const float* modb, int l, int r, int n) {
    float t = modb[l * 9216 + n];
#pragma unroll
    for (int kc = 0; kc < 8; ++kc) t += modp[((size_t)(l * 8 + kc) * 9 + r) * 9216 + n];
    return t;
}
DI void sincos_d(double ang, float& c, float& s) {
    const double k = __builtin_rint(ang * 0.15915494309189535);
    const double r = ang - k * 6.283185307179586;
    const double x2 = r * r;
    double P = 1.0, Q = 1.0;
#pragma unroll
    for (int i = 14; i >= 1; --i) { P = 1.0 - P * x2 * (1.0 / (double)((2 * i) * (2 * i + 1))); Q = 1.0 - Q * x2 * (1.0 / (double)((2 * i - 1) * (2 * i))); }
    s = (float)(r * P); c = (float)Q;
}

template <int DK>
DI void akey(const float (&q)[DK], float (&o)[64], float& m, float& l, const bf16_t* kp, const bf16_t* vp, float bias, bool valid) {
    float s = bias;
#pragma unroll
    for (int c = 0; c < DK / 8; ++c) { const u32x4 w = ((const u32x4*)kp)[c];
        s += q[8 * c] * bflo(w.x) + q[8 * c + 1] * bfhi(w.x) + q[8 * c + 2] * bflo(w.y) + q[8 * c + 3] * bfhi(w.y) + q[8 * c + 4] * bflo(w.z) + q[8 * c + 5] * bfhi(w.z) + q[8 * c + 6] * bflo(w.w) + q[8 * c + 7] * bfhi(w.w); }
    if (valid) {
        const float mn = fmaxf(m, s), al = __builtin_amdgcn_exp2f(m - mn), p = __builtin_amdgcn_exp2f(s - mn);
        l = l * al + p; m = mn;
#pragma unroll
        for (int c = 0; c < 8; ++c) { const u32x4 w = ((const u32x4*)vp)[c];
            o[8 * c] = o[8 * c] * al + p * bflo(w.x); o[8 * c + 1] = o[8 * c + 1] * al + p * bfhi(w.x); o[8 * c + 2] = o[8 * c + 2] * al + p * bflo(w.y); o[8 * c + 3] = o[8 * c + 3] * al + p * bfhi(w.y);
            o[8 * c + 4] = o[8 * c + 4] * al + p * bflo(w.z); o[8 * c + 5] = o[8 * c + 5] * al + p * bfhi(w.z); o[8 * c + 6] = o[8 * c + 6] * al + p * bflo(w.w); o[8 * c + 7] = o[8 * c + 7] * al + p * bfhi(w.w); }
    }
}
template <int MODE>
DI void attn_naive(const bf16_t* Q, const bf16_t* K, const bf16_t* V, const bf16_t* CK, const bf16_t* CV, bf16_t* O,
                   const float* sink, const float* rpb, const float* cqg, const float* csc, int gw, int ngw, int lane) {
    constexpr int DK = MODE == 2 ? 96 : 64;
    constexpr int G = (MODE <= 1) ? 4 : 1;
    constexpr int KS = MODE <= 1 ? 256 : (MODE == 2 ? 1536 : 1024);
    constexpr int VS = MODE <= 1 ? 256 : 1024;
    constexpr int QS = MODE == 2 ? 1536 : 1024;
    for (int it = gw; it < 3072; it += ngw) {
        const int h = it & 15, rbi = it >> 4, rb = rbi < 128 ? 64 + rbi : rbi - 128;
        const int row = rb * 64 + lane, kvh = h / G;
        const bool samp = rb >= 64;
        const int b = samp ? (rb - 64) >> 4 : rb >> 2, p0 = samp ? ((rb - 64) & 15) * 64 : 0, qpos = p0 + lane;
        float q[DK], o[64];
        { const u32x4* qp = (const u32x4*)(Q + (size_t)row * QS + h * DK);
#pragma unroll
          for (int c = 0; c < DK / 8; ++c) { const u32x4 w = qp[c]; q[8 * c] = bflo(w.x); q[8 * c + 1] = bfhi(w.x); q[8 * c + 2] = bflo(w.y); q[8 * c + 3] = bfhi(w.y); q[8 * c + 4] = bflo(w.z); q[8 * c + 5] = bfhi(w.z); q[8 * c + 6] = bflo(w.w); q[8 * c + 7] = bfhi(w.w); } }
        if (MODE == 2) {
            float ss = 0.f;
#pragma unroll
            for (int d = 0; d < DK; ++d) ss += q[d] * q[d];
            const float rinv = rsqrtf(ss * (1.f / 96.f) + EPS);
#pragma unroll
            for (int d = 0; d < DK; ++d) q[d] = q[d] * rinv * cqg[d];
            if (samp) {
#pragma unroll
                for (int i = 0; i < 16; ++i) { const f32x2 t = *(const f32x2*)(csc + ((size_t)qpos * 16 + i) * 2); const float x0 = q[64 + 2 * i], x1 = q[65 + 2 * i]; q[64 + 2 * i] = x0 * t.x - x1 * t.y; q[65 + 2 * i] = x0 * t.y + x1 * t.x; }
            }
#pragma unroll
            for (int d = 0; d < DK; ++d) q[d] *= QSCALE96;
        }
#pragma unroll
        for (int d = 0; d < 64; ++d) o[d] = 0.f;
        float m = -1e30f, l = 0.f;
        if (MODE == 0) { m = sink[h] * LOG2E; l = 1.f; }
        if (!samp) {
            const bf16_t* kb = K + (size_t)(b * 256) * KS + kvh * DK; const bf16_t* vb = V + (size_t)(b * 256) * VS + kvh * 64;
            for (int j = 0; j < 256; ++j) akey<DK>(q, o, m, l, kb + (size_t)j * KS, vb + (size_t)j * VS, 0.f, true);
        } else {
            const bf16_t* kb = K + (size_t)(MP + b * 1024) * KS + kvh * DK; const bf16_t* vb = V + (size_t)(MP + b * 1024) * VS + kvh * 64;
            if (MODE == 0) {
                const int lo = p0 - 128 < 0 ? 0 : p0 - 128, hi = p0 + 192 > 1024 ? 1024 : p0 + 192;
                for (int j = lo; j < hi; ++j) { const int dd = qpos - j; akey<DK>(q, o, m, l, kb + (size_t)j * KS, vb + (size_t)j * VS, 0.f, dd <= 128 && dd >= -128); }
            } else if (MODE == 3) {
                const int r = p0 >> 6, rs = r - 4 < 0 ? 0 : (r - 4 > 8 ? 8 : r - 4);
                const int cs0 = lane - 8 < 0 ? 0 : (lane - 8 > 48 ? 48 : lane - 8);
                for (int j = rs * 64; j < rs * 64 + 512; ++j) { const int kr = j >> 6, kc = j & 63; const bool valid = kc >= cs0 && kc < cs0 + 16;
                    const float bias = valid ? rpb[(h * 15 + (kr - r + 7)) * 31 + (kc - lane + 15)] * LOG2E : 0.f;
                    akey<DK>(q, o, m, l, kb + (size_t)j * KS, vb + (size_t)j * VS, bias, valid); }
            } else {
                for (int j = 0; j < 1024; ++j) akey<DK>(q, o, m, l, kb + (size_t)j * KS, vb + (size_t)j * VS, 0.f, true);
            }
            const bf16_t* ckb = CK + (size_t)(b * 512) * KS + kvh * DK; const bf16_t* cvb = CV + (size_t)(b * 512) * VS + kvh * 64;
            for (int j = 0; j < 512; ++j) akey<DK>(q, o, m, l, ckb + (size_t)j * KS, cvb + (size_t)j * VS, 0.f, true);
        }
        const float il = 1.f / l;
        u32x4* op = (u32x4*)(O + (size_t)row * 1024 + h * 64);
#pragma unroll
        for (int c = 0; c < 8; ++c) { u32x4 w; w.x = cvt_pk_bf16(o[8 * c] * il, o[8 * c + 1] * il); w.y = cvt_pk_bf16(o[8 * c + 2] * il, o[8 * c + 3] * il); w.z = cvt_pk_bf16(o[8 * c + 4] * il, o[8 * c + 5] * il); w.w = cvt_pk_bf16(o[8 * c + 6] * il, o[8 * c + 7] * il); op[c] = w; }
    }
}
typedef short bf16x8_t __attribute__((ext_vector_type(8)));
typedef float f32x16 __attribute__((ext_vector_type(16)));
typedef __bf16 bf16x2_t __attribute__((ext_vector_type(2)));
typedef short s16x4 __attribute__((ext_vector_type(4)));
typedef short v4i16_t __attribute__((ext_vector_type(4)));
DI unsigned cvtpk(float lo, float hi) { f32x2 v = {lo, hi}; bf16x2_t b = __builtin_convertvector(v, bf16x2_t); return __builtin_bit_cast(unsigned, b); }
DI s16x4 vtr(LAS unsigned char* p) { return __builtin_bit_cast(s16x4, __builtin_amdgcn_ds_read_tr16_b64_v4i16((LAS v4i16_t*)p)); }
DI int crow16(int i, int hh) { return (i & 3) + 8 * (i >> 2) + 4 * hh; }
DI int clampi(int v, int lo, int hi) { return v < lo ? lo : (v > hi ? hi : v); }

template <int MODE>
DI void attn_mfma(const bf16_t* Q, const bf16_t* K, const bf16_t* V, const bf16_t* CK, const bf16_t* CV, bf16_t* O,
                  const float* sink, const float* rpb, const float* cqg, const float* csc, LAS unsigned char* lds, int bx, int G, int tid, int wave) {
    constexpr int DK = MODE == 2 ? 96 : 64;
    constexpr int KS = MODE <= 1 ? 256 : (MODE == 2 ? 1536 : 1024);
    constexpr int VS = MODE <= 1 ? 256 : 1024;
    constexpr int QS = MODE == 2 ? 1536 : 1024;
    constexpr int KROWB = DK * 2 + 16, VROWB = 144, KBUF = 64 * KROWB, VBUF = 64 * VROWB;
    constexpr int OFF_V = 2 * KBUF, OFF_RPB = OFF_V + 2 * VBUF;
    constexpr int NS = DK / 16;
    const int lane = tid & 63, r = lane & 31, hh = lane >> 5;
    const int i16 = lane & 15, tq = i16 >> 2, tp = i16 & 3, tblk = (lane >> 4) & 1;
    LAS float* rpbL = (LAS float*)(lds + OFF_RPB);
    for (int item = bx; item < 768; item += G) {
        const bool samp = item < 512;
        int b, kvh, p0, head, q0;
        if (MODE <= 1) {
            if (samp) { b = item >> 6; kvh = (item >> 4) & 3; p0 = (item & 15) * 64; } else { const int j = item - 512; b = j >> 4; kvh = (j >> 2) & 3; p0 = (j & 3) * 64; }
            head = kvh * 4 + (wave >> 1); q0 = p0 + 32 * (wave & 1);
        } else {
            if (samp) { b = item >> 6; head = (item >> 2) & 15; p0 = (item & 3) * 256; } else { const int j = item - 512; b = j >> 4; head = j & 15; p0 = 0; }
            kvh = head; q0 = p0 + 32 * wave;
        }
        const int rowbase = samp ? MP + b * 1024 : b * 256;
        const int qrow = rowbase + q0 + r, qpos = q0 + r;
        bf16x8_t qf[NS];
        if (MODE != 2) {
#pragma unroll
            for (int s = 0; s < NS; ++s) qf[s] = *(const bf16x8_t*)(Q + (size_t)qrow * QS + head * DK + 16 * s + 8 * hh);
        } else {
            float v[NS][8]; float ss = 0.f;
#pragma unroll
            for (int s = 0; s < NS; ++s) { const u32x4 w = *(const u32x4*)(Q + (size_t)qrow * QS + head * DK + 16 * s + 8 * hh);
                v[s][0] = bflo(w.x); v[s][1] = bfhi(w.x); v[s][2] = bflo(w.y); v[s][3] = bfhi(w.y); v[s][4] = bflo(w.z); v[s][5] = bfhi(w.z); v[s][6] = bflo(w.w); v[s][7] = bfhi(w.w);
#pragma unroll
                for (int j = 0; j < 8; ++j) ss += v[s][j] * v[s][j]; }
            ss += __shfl_xor(ss, 32);
            const float rinv = rsqrtf(ss * (1.f / 96.f) + EPS) ;
#pragma unroll
            for (int s = 0; s < NS; ++s) { const f32x4 g0 = *(const f32x4*)(cqg + 16 * s + 8 * hh), g1 = *(const f32x4*)(cqg + 16 * s + 8 * hh + 4);
#pragma unroll
                for (int j = 0; j < 4; ++j) { v[s][j] *= rinv * g0[j]; v[s][4 + j] *= rinv * g1[j]; }
                if (s >= 4 && samp) {
                    const float* cp = csc + ((size_t)qpos * 16 + 8 * (s - 4) + 4 * hh) * 2;
                    const f32x4 t0 = *(const f32x4*)cp, t1 = *(const f32x4*)(cp + 4);
                    float a0 = v[s][0], a1 = v[s][1]; v[s][0] = a0 * t0.x - a1 * t0.y; v[s][1] = a0 * t0.y + a1 * t0.x;
                    a0 = v[s][2]; a1 = v[s][3]; v[s][2] = a0 * t0.z - a1 * t0.w; v[s][3] = a0 * t0.w + a1 * t0.z;
                    a0 = v[s][4]; a1 = v[s][5]; v[s][4] = a0 * t1.x - a1 * t1.y; v[s][5] = a0 * t1.y + a1 * t1.x;
                    a0 = v[s][6]; a1 = v[s][7]; v[s][6] = a0 * t1.z - a1 * t1.w; v[s][7] = a0 * t1.w + a1 * t1.z;
                }
                u32x4 w; w.x = cvtpk(v[s][0] * QSCALE96, v[s][1] * QSCALE96); w.y = cvtpk(v[s][2] * QSCALE96, v[s][3] * QSCALE96); w.z = cvtpk(v[s][4] * QSCALE96, v[s][5] * QSCALE96); w.w = cvtpk(v[s][6] * QSCALE96, v[s][7] * QSCALE96);
                qf[s] = __builtin_bit_cast(bf16x8_t, w); }
        }
        int nlat, lat0, klo = 0, ncache = samp ? 8 : 0;
        if (!samp) { lat0 = rowbase; nlat = 4; }
        else if (MODE == 0) { const int lo = p0 - 128 < 0 ? 0 : p0 - 128, hi = p0 + 192 > 1024 ? 1024 : p0 + 192; lat0 = rowbase + lo; nlat = (hi - lo) >> 6; klo = lo; }
        else if (MODE == 3) { const int r0 = p0 >> 6, lo = clampi(r0 - 4, 0, 8), hi = clampi(r0 - 1, 0, 8) + 8; lat0 = rowbase + lo * 64; nlat = hi - lo; klo = lo; }
        else { lat0 = rowbase; nlat = 16; }
        const int nt = nlat + ncache;
        if (MODE == 3) { for (int i = tid; i < 465; i += NTHR) rpbL[i] = rpb[head * 465 + i] * LOG2E; }
        u32x4 kst0, kst1, vst;
        const int kkey0 = DK == 64 ? tid >> 3 : tid / 12, kc0 = DK == 64 ? tid & 7 : tid % 12;
        const int kkey1 = (tid + 512) / 12, kc1 = (tid + 512) % 12;
        const int vkey = tid >> 3, vc = tid & 7;
#define ATT_LOAD(T) do { const int t_ = (T); const bf16_t* kp_; const bf16_t* vp_; \
            if (t_ < nlat) { kp_ = K + (size_t)(lat0 + 64 * t_) * KS + kvh * DK; vp_ = V + (size_t)(lat0 + 64 * t_) * VS + kvh * 64; } \
            else { kp_ = CK + (size_t)(b * 512 + 64 * (t_ - nlat)) * KS + kvh * DK; vp_ = CV + (size_t)(b * 512 + 64 * (t_ - nlat)) * VS + kvh * 64; } \
            kst0 = *(const u32x4*)(kp_ + (size_t)kkey0 * KS + kc0 * 8); \
            if (DK == 96 && tid < 256) kst1 = *(const u32x4*)(kp_ + (size_t)kkey1 * KS + kc1 * 8); \
            vst = *(const u32x4*)(vp_ + (size_t)vkey * VS + vc * 8); } while (0)
#define ATT_STORE(B) do { LAS unsigned char* kb_ = lds + (B) * KBUF; LAS unsigned char* vb_ = lds + OFF_V + (B) * VBUF; \
            *(LAS u32x4*)(kb_ + kkey0 * KROWB + kc0 * 16) = kst0; \
            if (DK == 96 && tid < 256) *(LAS u32x4*)(kb_ + kkey1 * KROWB + kc1 * 16) = kst1; \
            *(LAS u32x4*)(vb_ + vkey * VROWB + vc * 16) = vst; } while (0)
        ATT_LOAD(0); ATT_STORE(0);
        __syncthreads();
        f32x16 o0, o1;
#pragma unroll
        for (int i = 0; i < 16; ++i) { o0[i] = 0.f; o1[i] = 0.f; }
        float l = 0.f;
        if (MODE == 0) l = hh == 0 ? __builtin_amdgcn_exp2f(sink[head] * LOG2E) : 0.f;
        const int rq = (q0 >> 6), qc = (q0 & 63) + r, rsw = clampi(rq - 4, 0, 8), cs0 = clampi(qc - 8, 0, 48);
        for (int t = 0; t < nt; ++t) {
            if (t + 1 < nt) ATT_LOAD(t + 1);
            LAS unsigned char* kbuf = lds + (t & 1) * KBUF; LAS unsigned char* vbuf = lds + OFF_V + (t & 1) * VBUF;
            const bool lat = samp && t < nlat;
            bool active = true;
            if (MODE == 3 && lat) { const int kr = klo + t; active = kr >= rsw && kr < rsw + 8; }
            if (active) {
                f32x16 s0, s1;
#pragma unroll
                for (int i = 0; i < 16; ++i) { s0[i] = 0.f; s1[i] = 0.f; }
#pragma unroll
                for (int s = 0; s < NS; ++s) {
                    const bf16x8_t k0 = *(LAS bf16x8_t*)(kbuf + r * KROWB + (16 * s + 8 * hh) * 2);
                    const bf16x8_t k1 = *(LAS bf16x8_t*)(kbuf + (32 + r) * KROWB + (16 * s + 8 * hh) * 2);
                    s0 = __builtin_amdgcn_mfma_f32_32x32x16_bf16(k0, qf[s], s0, 0, 0, 0);
                    s1 = __builtin_amdgcn_mfma_f32_32x32x16_bf16(k1, qf[s], s1, 0, 0, 0);
                }
                if (MODE == 0 && lat) {
                    const int kbase = klo + 64 * t;
                    if (kbase + 63 - q0 > 128 || q0 + 31 - kbase > 128) {
#pragma unroll
                        for (int i = 0; i < 16; ++i) { const int d0 = qpos - (kbase + crow16(i, hh)), d1 = d0 - 32;
                            if (d0 > 128 || d0 < -128) s0[i] = -INFINITY; if (d1 > 128 || d1 < -128) s1[i] = -INFINITY; }
                    }
                }
                if (MODE == 3 && lat) {
                    const int kr = klo + t; const LAS float* rp = rpbL + (kr - rq + 7) * 31 + 15 - qc;
#pragma unroll
                    for (int i = 0; i < 16; ++i) { const int kc = crow16(i, hh), kc2 = kc + 32;
                        const bool v0 = kc >= cs0 && kc < cs0 + 16, v1 = kc2 >= cs0 && kc2 < cs0 + 16;
                        const float b0 = rp[clampi(kc, qc - 15, qc + 15)], b1 = rp[clampi(kc2, qc - 15, qc + 15)];
                        s0[i] = v0 ? s0[i] + b0 : -INFINITY; s1[i] = v1 ? s1[i] + b1 : -INFINITY; }
                }
                float rs = 0.f;
#pragma unroll
                for (int i = 0; i < 16; ++i) { s0[i] = __builtin_amdgcn_exp2f(s0[i]); s1[i] = __builtin_amdgcn_exp2f(s1[i]); rs += s0[i] + s1[i]; }
                l += rs;
#pragma unroll
                for (int kb = 0; kb < 2; ++kb)
#pragma unroll
                    for (int s2 = 0; s2 < 2; ++s2) {
                        u32x4 pw;
                        if (kb == 0) { pw.x = cvtpk(s0[8 * s2], s0[8 * s2 + 1]); pw.y = cvtpk(s0[8 * s2 + 2], s0[8 * s2 + 3]); pw.z = cvtpk(s0[8 * s2 + 4], s0[8 * s2 + 5]); pw.w = cvtpk(s0[8 * s2 + 6], s0[8 * s2 + 7]); }
                        else { pw.x = cvtpk(s1[8 * s2], s1[8 * s2 + 1]); pw.y = cvtpk(s1[8 * s2 + 2], s1[8 * s2 + 3]); pw.z = cvtpk(s1[8 * s2 + 4], s1[8 * s2 + 5]); pw.w = cvtpk(s1[8 * s2 + 6], s1[8 * s2 + 7]); }
                        const bf16x8_t pb = __builtin_bit_cast(bf16x8_t, pw);
                        LAS unsigned char* vp = vbuf + (32 * kb + 16 * s2 + 4 * hh + tq) * VROWB + (16 * tblk + 4 * tp) * 2;
                        const s16x4 a0 = vtr(vp), a1 = vtr(vp + 8 * VROWB), c0 = vtr(vp + 64), c1 = vtr(vp + 8 * VROWB + 64);
                        const bf16x8_t vf0 = __builtin_shufflevector(a0, a1, 0, 1, 2, 3, 4, 5, 6, 7), vf1 = __builtin_shufflevector(c0, c1, 0, 1, 2, 3, 4, 5, 6, 7);
                        o0 = __builtin_amdgcn_mfma_f32_32x32x16_bf16(vf0, pb, o0, 0, 0, 0);
                        o1 = __builtin_amdgcn_mfma_f32_32x32x16_bf16(vf1, pb, o1, 0, 0, 0);
                    }
            }
            if (t + 1 < nt) ATT_STORE((t + 1) & 1);
            __syncthreads();
        }
#undef ATT_LOAD
#undef ATT_STORE
        l += __shfl_xor(l, 32);
        const float il = 1.f / l;
        bf16_t* op = O + (size_t)qrow * 1024 + head * 64 + 4 * hh;
#pragma unroll
        for (int g = 0; g < 4; ++g) {
            u32x2 w0, w1;
            w0.x = cvtpk(o0[4 * g] * il, o0[4 * g + 1] * il); w0.y = cvtpk(o0[4 * g + 2] * il, o0[4 * g + 3] * il);
            w1.x = cvtpk(o1[4 * g] * il, o1[4 * g + 1] * il); w1.y = cvtpk(o1[4 * g + 2] * il, o1[4 * g + 3] * il);
            *(u32x2*)(op + 8 * g) = w0; *(u32x2*)(op + 32 + 8 * g) = w1;
        }
    }
}
__constant__ double q4[4] = {1.0, 0.5623413251903491, 0.31622776601683794, 0.1778279410038923};
__constant__ double p10[4] = {1.0, 0.1, 0.01, 0.001};
#ifndef SITE_MASK
#define SITE_MASK 0xff
#endif
#define SITE(n) (((SITE_MASK) >> (n)) & 1)
#ifndef REP_MASK
#define REP_MASK 0
#endif
#ifndef NAIVE_ATTN
#define NAIVE_ATTN 0
#endif
#if NAIVE_ATTN
#define ATTN attn_naive
#define ATTN_TAIL gw, ngw, lane
#else
#define ATTN attn_mfma
#define ATTN_TAIL lds, bx, G, tid, wave
#endif
#ifndef NOATTN
#define NOATTN 0
#endif
#ifndef NOP0
#define NOP0 0
#endif
#define PGALIGN true
#define PGSP2 true
#define XB_TMO      128
#define XB_XCNT(j)  (256  + 64 * (j))
#define XB_XSUB(j)  (1280 + 64 * (j))
#define XB_XGEN(j)  (2304 + 64 * (j))
#define XB_TOP      3328
#define XB_TOPGEN   3392
#define XB_SPIN_CAP (1u << 20)
DI unsigned xb_ld(unsigned* p) { return __hip_atomic_load(p, __ATOMIC_RELAXED, __HIP_MEMORY_SCOPE_AGENT); }
DI unsigned xb_add(unsigned* p, unsigned v) { return __hip_atomic_fetch_add(p, v, __ATOMIC_RELAXED, __HIP_MEMORY_SCOPE_AGENT); }
DI unsigned xb_xcc_id() { return (unsigned)__builtin_amdgcn_s_getreg((3 << 11) | 20) & 0xFu; }
#define XB_SPIN(cond, bar) do { unsigned _sp = 0; while (cond) { __builtin_amdgcn_s_sleep(1); \
    if ((++_sp & 255u) == 0u) { if (xb_ld(&(bar)[XB_TMO])) break; if (_sp > XB_SPIN_CAP) { atomicAdd(&(bar)[XB_TMO], 1u); break; } } } } while (0)
DI void xcd_barrier_complete(unsigned* bar, unsigned x, unsigned G, unsigned& nloc, unsigned& nx) {
    unsigned sum, cnt, mine, sp = 0u;
    for (;;) {
        sum = 0u; cnt = 0u; mine = 0u;
#pragma unroll
        for (unsigned j = 0; j < 16; ++j) { const unsigned c = xb_ld(&bar[XB_XCNT(j)]); sum += c; cnt += (c > 0u) ? 1u : 0u; mine = (j == x) ? c : mine; }
        if (sum == G) break;
        __builtin_amdgcn_s_sleep(1);
        if ((++sp & 255u) == 0u) { if (xb_ld(&bar[XB_TMO])) break; if (sp > XB_SPIN_CAP) { atomicAdd(&bar[XB_TMO], 1u); break; } }
    }
    nloc = mine > 0u ? mine : 1u; nx = cnt > 0u ? cnt : 1u;
}
DI void grid_bar(unsigned* bar, volatile LAS unsigned* st, int tid) {
    asm volatile("s_waitcnt vmcnt(0)" ::: "memory");
    __syncthreads();
    if (tid == 0) {
        __builtin_amdgcn_s_waitcnt(0);
        const unsigned x = xb_xcc_id();
        unsigned nloc = st[0], nx = st[1];
        if (nloc == 0u) { xcd_barrier_complete(bar, x, gridDim.x, nloc, nx); st[0] = nloc; st[1] = nx; }
        const unsigned old = xb_add(&bar[XB_XSUB(x)], 1u);
        const unsigned gen = old / nloc;
        if (old + 1u == (gen + 1u) * nloc) {
            __builtin_amdgcn_fence(__ATOMIC_RELEASE, "agent");
            asm volatile("s_waitcnt vmcnt(0)" ::: "memory");
            const unsigned og = xb_add(&bar[XB_TOP], 1u);
            const unsigned tg = og / nx;
            if (og + 1u == (tg + 1u) * nx) xb_add(&bar[XB_TOPGEN], 1u);
            else XB_SPIN(xb_ld(&bar[XB_TOPGEN]) == tg, bar);
            __builtin_amdgcn_fence(__ATOMIC_ACQUIRE, "agent");
            xb_add(&bar[XB_XGEN(x)], 1u);
            asm volatile("s_waitcnt vmcnt(0)" ::: "memory");
        } else {
            XB_SPIN(xb_ld(&bar[XB_XGEN(x)]) == gen, bar);
            __builtin_amdgcn_fence(__ATOMIC_ACQUIRE, "agent");
            asm volatile("s_waitcnt vmcnt(0)" ::: "memory");
        }
    }
    __syncthreads();
}
constexpr size_t CTL_HEAD_OFF = 16384, CTL_CNT_OFF = 32768, CTL_BYTES = 262144;
struct QueueOrder {
    unsigned* head; const unsigned* dep; unsigned need; unsigned* pub;
    int lo, hi, ntn, gsz, x, first; int* carry; volatile LAS int* mail; int wave, lane;
    DI void decode(int t, pg8::Unit& u) const { const int j = t - lo, per = gsz * ntn, g = j / per, r = j - g * per; u.pn = r / gsz; u.pm = x + 8 * (g * gsz + (r - u.pn * gsz)); }
    DI bool next(int i, pg8::Unit& u) const {
        int t = first, ready = 1;
        if (i != 0) {
            if (i == 1 && wave == 0) {
                int tt = 0;
                if (lane == 0) tt = (int)__hip_atomic_fetch_add(head, 1u, __ATOMIC_RELAXED, __HIP_MEMORY_SCOPE_AGENT);
                tt = __builtin_amdgcn_readfirstlane(tt);
                int rd = 1;
                if (tt < hi && dep) { pg8::Unit v; decode(tt, v); if (v.pm < 48) rd = __builtin_amdgcn_readfirstlane((int)(__hip_atomic_load(dep + 16 * v.pm, __ATOMIC_RELAXED, __HIP_MEMORY_SCOPE_AGENT) >= need)); }
                if (lane == 0) { mail[0] = tt; mail[1] = rd; mail[2] = 0; }
                asm volatile("s_waitcnt vmcnt(0) lgkmcnt(0)" ::: "memory");
            }
            asm volatile("" ::: "memory"); __builtin_amdgcn_s_barrier(); asm volatile("" ::: "memory");
            t = __builtin_amdgcn_readfirstlane(mail[0]); ready = __builtin_amdgcn_readfirstlane(mail[1]);
            *carry = t;
            if (t >= hi || !ready) { if (wave == 0 && lane == 0) mail[2] = 1; return false; }
            decode(t, u); return true;
        }
        decode(t, u); return true;
    }
    DI void a_ready(const pg8::Unit& u) const {
        if (dep && u.pm < 48) {
            if (wave == 0) {
                unsigned sp = 0;
                while ((unsigned)__builtin_amdgcn_readfirstlane((int)__hip_atomic_load(dep + 16 * u.pm, __ATOMIC_RELAXED, __HIP_MEMORY_SCOPE_AGENT)) < need) { __builtin_amdgcn_s_sleep(2); if (++sp > (1u << 22)) break; }
                __builtin_amdgcn_fence(__ATOMIC_ACQUIRE, "agent");
                asm volatile("s_waitcnt vmcnt(0)" ::: "memory");
            }
            asm volatile("" ::: "memory"); __builtin_amdgcn_s_barrier(); asm volatile("" ::: "memory");
        }
    }
    DI void done(const pg8::Unit& u) const {
        const int holding = __builtin_amdgcn_readfirstlane(mail[2]);
        int tt = 0;
        if (!holding && wave == 0 && lane == 0) tt = (int)__hip_atomic_fetch_add(head, 1u, __ATOMIC_RELAXED, __HIP_MEMORY_SCOPE_AGENT);
        asm volatile("s_waitcnt vmcnt(0)" : "+v"(tt) :: "memory");
        if (pub && lane == 0) (void)__hip_atomic_fetch_add(pub + 16 * u.pm, 1u, __ATOMIC_RELAXED, __HIP_MEMORY_SCOPE_AGENT);
        if (!holding && wave == 0) {
            tt = __builtin_amdgcn_readfirstlane(tt);
            int rd = 1;
            if (tt < hi && dep) { pg8::Unit v; decode(tt, v); if (v.pm < 48) rd = __builtin_amdgcn_readfirstlane((int)(__hip_atomic_load(dep + 16 * v.pm, __ATOMIC_RELAXED, __HIP_MEMORY_SCOPE_AGENT) >= need)); }
            if (lane == 0) { mail[0] = tt; mail[1] = rd; }
            asm volatile("s_waitcnt vmcnt(0) lgkmcnt(0)" ::: "memory");
        }
    }
};
template <class Epi>
DI void run_stage(LAS unsigned char* lds, int& t, int lo, int ntn, int npan, const bf16_t* A, const bf16_t* Bt, int Mrows, int K, const Epi& E,
                  unsigned* head, const unsigned* dep, unsigned need, unsigned* pub, int x, int wave_s) {
    const int hi = lo + ntn * npan;
    while (t >= lo && t < hi) {
        int tid = wave_s * 64 + (int)__builtin_amdgcn_mbcnt_hi(~0u, __builtin_amdgcn_mbcnt_lo(~0u, 0u)); asm volatile("" : "+v"(tid));
        QueueOrder S{head, dep, need, pub, lo, hi, ntn, npan / 2, x, t, &t, (volatile LAS int*)(lds + RING_BYTES + 1024), wave_s, tid & 63};
        pg8::Gemm gg{A, Bt, Mrows, ntn * 256, K};
        pg8::gemm_phase<Epi, QueueOrder, PGALIGN, PGSP2>(lds, gg, S, E, tid);
    }
}
template <int ph> DI bool run_phase(const Args& a, LAS unsigned char* lds, int wave_s) {
        bool did = true;
        int tid = wave_s * 64 + (int)__builtin_amdgcn_mbcnt_hi(~0u, __builtin_amdgcn_mbcnt_lo(~0u, 0u)); asm volatile("" : "+v"(tid));
        int bx = blockIdx.x; asm volatile("" : "+s"(bx));
        const int lane = tid & 63, wave = wave_s;
        const int G = gridDim.x;
        const int gw = bx * NWAVES + wave, ngw = G * NWAVES;
        const size_t gt = (size_t)bx * NTHR + tid, ngt = (size_t)G * NTHR;
    unsigned char* ws = a.ws; asm volatile("" : "+s"(ws));
    float* X = a.out; asm volatile("" : "+s"(X));
    bf16_t* xs = (bf16_t*)(ws + O_XS); bf16_t* act = (bf16_t*)(ws + O_ACT); bf16_t* qb = (bf16_t*)(ws + O_Q); bf16_t* kb = (bf16_t*)(ws + O_K); bf16_t* vb = (bf16_t*)(ws + O_V);
    bf16_t* ob = (bf16_t*)(ws + O_OB); bf16_t* cqs = (bf16_t*)(ws + O_CQS); bf16_t* ckvs = (bf16_t*)(ws + O_CKVS); float* krb = (float*)(ws + O_KR);
    bf16_t* cache = (bf16_t*)(ws + O_CACHE); float* stats = (float*)(ws + O_STATS); float* cst = (float*)(ws + O_CSTATS);
    float* modp = (float*)(ws + O_MODP); float* mod = (float*)(ws + O_MOD); float* gs = (float*)(ws + O_GS); bf16_t* sha = (bf16_t*)(ws + O_SHA); float* bias = (float*)(ws + O_BIAS);
    float* cshd = (float*)(ws + O_CSHD); float* csc = (float*)(ws + O_CSC);

        if (ph == 0 && !NOP0) {
            LAS float* scr = (LAS float*)(lds + wave * 16384);
            constexpr int I_GU = 16 * 176, I_DN = 44 * 32, I_L = 2 * (I_GU + I_DN);
            constexpr int I_AQ = 16 * 48, I_O = 16 * 32, I_CD = 16 * 21, I_CUQ = 6 * 48, I_CUKV = 4 * 64, I_DQ = 16 * 96;
            constexpr int NIT = 4 * I_L + 2 * (I_AQ + I_O) + I_CD + I_CUQ + I_CUKV + I_O + I_DQ + I_O;
#define TR(SRC, KK, NN, PERM, DST, CNT) { if (r < (CNT)) { transpose_item((SRC), (KK), (NN), (bf16_t*)(ws + (DST)), (PERM), r, lane); continue; } r -= (CNT); }
            for (int it = gw; it < NIT; it += ngw) {
                int r = it;
                if (r < 4 * I_L) { const int l = r / I_L; r -= l * I_L;
                    TR(a.in[17] + (size_t)l * D * NGU, D, NGU, 1, O_WGU + (size_t)(2 * l) * SZ_WGU, I_GU)
                    TR(a.in[19] + (size_t)l * D * NGU, D, NGU, 1, O_WGU + (size_t)(2 * l + 1) * SZ_WGU, I_GU)
                    TR(a.in[18] + (size_t)l * DFF * D, DFF, D, 0, O_WDN + (size_t)(2 * l) * SZ_WDN, I_DN)
                    TR(a.in[20] + (size_t)l * DFF * D, DFF, D, 0, O_WDN + (size_t)(2 * l + 1) * SZ_WDN, I_DN)
                    continue; }
                r -= 4 * I_L;
                TR(a.in[21], D, 1536, 2, O_WAQKV, I_AQ)
                TR(a.in[25], D, D, 0, O_WAO, I_O)
                TR(a.in[26], D, 1536, 2, O_WBQKV, I_AQ)
                TR(a.in[29], D, D, 0, O_WBO, I_O)
                TR(a.in[30], D, 672, 0, O_WCDN, I_CD)
                TR(a.in[33], 384, 1536, 0, O_WCUQ, I_CUQ)
                TR(a.in[34], 256, 2048, 2, O_WCUKV, I_CUKV)
                TR(a.in[37], D, D, 0, O_WCO, I_O)
                TR(a.in[38], D, 3072, 2, O_WDQKV, I_DQ)
                TR(a.in[42], D, D, 0, O_WDO, I_O)
            }
#undef TR
            for (int it = gw; it < 4 * 36 * 8; it += ngw) {
                const int l = it / 288, rem = it % 288, nb = rem >> 3, kc = rem & 7, k0 = kc * 128, n0 = nb * 256 + lane * 4;
                for (int idx = lane; idx < 9 * 128; idx += 64) { const int r = idx >> 7, kk = idx & 127; const float c = r == 0 ? a.in[11][k0 + kk] : a.in[10][(r - 1) * D + k0 + kk]; scr[idx] = silu_f(c); }
                LDS_WAIT(); asm volatile("" ::: "memory");
                f32x4 ac[9];
#pragma unroll
                for (int r = 0; r < 9; ++r) ac[r] = (f32x4){0.f, 0.f, 0.f, 0.f};
                const float* wp = a.in[12] + ((size_t)l * D + k0) * 9216 + n0;
#pragma unroll 8
                for (int kk = 0; kk < 128; ++kk) { const f32x4 w = *(const f32x4*)(wp + (size_t)kk * 9216);
#pragma unroll
                    for (int r = 0; r < 9; ++r) ac[r] += w * scr[r * 128 + kk]; }
#pragma unroll
                for (int r = 0; r < 9; ++r) *(f32x4*)(modp + ((size_t)(l * 8 + kc) * 9 + r) * 9216 + n0) = ac[r];
                LDS_WAIT(); asm volatile("" ::: "memory");
            }
            cvt_range(a.in[2], cache, 131072, gt, ngt); cvt_range(a.in[3], cache + 1048576, 131072, gt, ngt);
            cvt_range(a.in[4], cache + 2 * 1048576, 131072, gt, ngt); cvt_range(a.in[5], cache + 3 * 1048576, 131072, gt, ngt);
            cvt_range(a.in[8], cache + 4 * 1048576, 524288, gt, ngt); cvt_range(a.in[9], cache + 8 * 1048576, 524288, gt, ngt);
            cvt_range(a.in[6], ckvs + (size_t)M * 256, 131072, gt, ngt);
            for (size_t i = gt; i < 1024 * 48; i += ngt) {
                const int pos = (int)(i / 48), t = (int)(i % 48);
                double ang; float c, s;
                if (t < 32) { const int ii = t & 15; ang = (double)(t < 16 ? pos >> 6 : pos & 63) * (q4[ii & 3] * p10[ii >> 2]); sincos_d(ang, c, s); cshd[((size_t)pos * 32 + t) * 2] = c; cshd[((size_t)pos * 32 + t) * 2 + 1] = s; }
                else { const int t2 = t - 32, ii = t2 & 7; ang = (double)(t2 < 8 ? pos >> 6 : pos & 63) * (q4[(ii & 1) * 2] * p10[ii >> 1]); sincos_d(ang, c, s); csc[((size_t)pos * 16 + t2) * 2] = c; csc[((size_t)pos * 16 + t2) * 2 + 1] = s; }
            }
        } else if (ph == 1) {
            for (size_t i = gt; i < 4 * 9 * 9216; i += ngt) { const int l = (int)(i / (9 * 9216)), r = (int)((i / 9216) % 9), n = (int)(i % 9216); mod[i] = modval(modp, a.in[13], l, r, n); }
            for (size_t i = gt; i < 4 * 3 * 9 * 1024; i += ngt) {
                const int k = (int)(i & 1023), r = (int)((i >> 10) % 9), nm = (int)((i / 9216) % 3), l = (int)(i / 27648);
                const float g = a.in[14 + nm][l * D + k];
                gs[i] = g * (1.f + modval(modp, a.in[13], l, r, (3 * nm + 1) * 1024 + k));
                const float sh = modval(modp, a.in[13], l, r, (3 * nm) * 1024 + k);
                sha[((size_t)(l * 3 + nm) * 256 + r) * 1024 + k] = (bf16_t)(cvt_pk_bf16(sh, 0.f) & 0xffffu);
            }
        } else if (ph == 2) {
            int off = 0;
            for (int g = 0; g < 12; ++g) {
                const int l = g / 3, nm = g % 3;
                const bf16_t* Bt; int N;
                if (nm != 1) { Bt = (const bf16_t*)(ws + O_WGU + (size_t)(2 * l + (nm == 2)) * SZ_WGU); N = NGU; }
                else if (l == 0) { Bt = (const bf16_t*)(ws + O_WAQKV); N = 1536; } else if (l == 1) { Bt = (const bf16_t*)(ws + O_WBQKV); N = 1536; }
                else if (l == 2) { Bt = (const bf16_t*)(ws + O_WCDN); N = 768; } else { Bt = (const bf16_t*)(ws + O_WDQKV); N = 3072; }
                pg8::Gemm gg{sha + (size_t)g * 256 * 1024, Bt, 256, N, D}; pg8::StaticOrder S; S.init(256, N, G, (bx + G - (off % G)) % G);
                EpiBias E{bias + (size_t)g * 9 * NGU};
                if (SITE(0)) pg8::gemm_phase<EpiBias, pg8::StaticOrder, PGALIGN, PGSP2>(lds, gg, S, E, tid);
                off += N / 256;
            }
            for (int m = gw; m < M; m += ngw) {
                const int mr = mrow_of_tile(m >> 8);
                const f32x4* xr = (const f32x4*)(m < MP ? a.in[0] + (size_t)m * D : a.in[1] + (size_t)(m - MP) * D) + lane; const f32x4* gr = (const f32x4*)(gs + (size_t)mr * 1024) + lane;
                float ss = 0.f;
#pragma unroll
                for (int j = 0; j < 4; ++j) { const f32x4 v = xr[64 * j], g4 = gr[64 * j]; ss += sq4(v); const f32x4 w = v * g4;
                    u32x2 o; o.x = cvt_pk_bf16(w.x, w.y); o.y = cvt_pk_bf16(w.z, w.w); *((u32x2*)(xs + (size_t)m * D) + lane + 64 * j) = o; }
                ss = wave_sum(ss);
                if (lane < 16) stats[(size_t)m * 16 + lane] = lane == 0 ? ss : 0.f;
            }
        } else if ((ph & 1) == 0) {
            constexpr int l = (ph - 4) >> 1;
            if (l == 2) { float* okv = a.out + OUT_CKV;
                for (int m = gw; m < MP; m += ngw) { const float r = rsqrtf(cst_sum(cst, m, 12, 2) * (1.f / 256.f) + EPS); f32x4* p = (f32x4*)(okv + (size_t)m * 256) + lane; *p = *p * r; } }
            if (l == 0) ATTN<0>(qb, kb, vb, cache, cache + 1048576, ob, a.in[24], nullptr, nullptr, nullptr, ATTN_TAIL);
            else if (l == 1) ATTN<1>(qb, kb, vb, cache + 2 * 1048576, cache + 3 * 1048576, ob, nullptr, nullptr, nullptr, nullptr, ATTN_TAIL);
            else if (l == 2) ATTN<2>(qb, kb, vb, kb + (size_t)M * 1536, vb + (size_t)M * 1024, ob, nullptr, nullptr, a.in[35], csc, ATTN_TAIL);
            else ATTN<3>(qb, kb, vb, cache + 4 * 1048576, cache + 8 * 1048576, ob, nullptr, a.in[41], nullptr, nullptr, ATTN_TAIL);
        } else {
            constexpr int sg = (ph - 3) >> 1;
            const int x = (int)(xb_xcc_id() & 7u);
            unsigned* ctl = (unsigned*)(ws + O_CTL);
            unsigned* head = ctl + CTL_HEAD_OFF / 4 + (sg * 8 + x) * 64;
            unsigned* cntb = ctl + CTL_CNT_OFF / 4 + (size_t)(sg * 10) * 64 * 16;
            volatile LAS int* mail = (volatile LAS int*)(lds + RING_BYTES + 1024);
            if (wave == 0) { int tt = 0; if (lane == 0) tt = (int)__hip_atomic_fetch_add(head, 1u, __ATOMIC_RELAXED, __HIP_MEMORY_SCOPE_AGENT); tt = __builtin_amdgcn_readfirstlane(tt); if (lane == 0) mail[0] = tt; }
            __syncthreads();
            int t = __builtin_amdgcn_readfirstlane(mail[0]);
            __syncthreads();
            int lo = 0, k = 0; const unsigned* dep = nullptr; unsigned need = 0;
#define STAGE_ADV(NTN, NPAN) do { lo += (NTN) * (NPAN); dep = cntb + (size_t)k * 64 * 16; need = 8u * (NTN); ++k; } while (0)
            if (sg >= 1) {
                constexpr int l = sg - 1;
                const float* modl = mod + (size_t)l * 9 * 9216;
                { EpiRes E{X, modl + 5 * 1024, gs + (size_t)(l * 3 + 2) * 9 * 1024, xs, stats, X, X, 1.f, 0.f};
                  run_stage<EpiRes>(lds, t, lo, 4, 6, ob, (const bf16_t*)(ws + (l == 0 ? O_WAO : l == 1 ? O_WBO : l == 2 ? O_WCO : O_WDO)), M, D, E, head, dep, need, cntb + (size_t)k * 64 * 16, x, wave_s); STAGE_ADV(4, 6); }
                { EpiGU E{stats, bias + (size_t)(l * 3 + 2) * 9 * NGU, act};
                  run_stage<EpiGU>(lds, t, lo, 22, 6, xs, (const bf16_t*)(ws + O_WGU + (size_t)(2 * l + 1) * SZ_WGU), M, D, E, head, dep, need, cntb + (size_t)k * 64 * 16, x, wave_s); STAGE_ADV(22, 6); }
                { EpiRes E{X, modl + 8 * 1024, l < 3 ? gs + (size_t)((l + 1) * 3) * 9 * 1024 : nullptr, xs, stats, X, X, 0.5f, 0.f};
                  run_stage<EpiRes>(lds, t, lo, 4, 6, act, (const bf16_t*)(ws + O_WDN + (size_t)(2 * l + 1) * SZ_WDN), M, DFF, E, head, dep, need, sg <= 3 ? cntb + (size_t)k * 64 * 16 : nullptr, x, wave_s); STAGE_ADV(4, 6); }
            }
            if (sg <= 3) {
                constexpr int l = sg;
                const float* modl = mod + (size_t)l * 9 * 9216;
                { EpiGU E{stats, bias + (size_t)(l * 3) * 9 * NGU, act};
                  run_stage<EpiGU>(lds, t, lo, 22, 6, xs, (const bf16_t*)(ws + O_WGU + (size_t)(2 * l) * SZ_WGU), M, D, E, head, dep, need, cntb + (size_t)k * 64 * 16, x, wave_s); STAGE_ADV(22, 6); }
                { EpiRes E{X, modl + 2 * 1024, gs + (size_t)(l * 3 + 1) * 9 * 1024, xs, stats, sg == 0 ? a.in[0] : X, sg == 0 ? a.in[1] - (size_t)MP * D : X, 0.5f, 0.f};
                  run_stage<EpiRes>(lds, t, lo, 4, 6, act, (const bf16_t*)(ws + O_WDN + (size_t)(2 * l) * SZ_WDN), M, DFF, E, head, dep, need, cntb + (size_t)k * 64 * 16, x, wave_s); STAGE_ADV(4, 6); }
                const float* bl = bias + (size_t)(l * 3 + 1) * 9 * NGU;
                if (l == 2) {
                    { EpiCDown E{stats, bl, a.in[31], a.in[32], cqs, ckvs, krb, cst, a.out + OUT_CKV, a.out + OUT_CKR};
                      run_stage<EpiCDown>(lds, t, lo, 3, 6, xs, (const bf16_t*)(ws + O_WCDN), M, D, E, head, dep, need, cntb + (size_t)k * 64 * 16, x, wave_s); STAGE_ADV(3, 6); }
                    { int kq = 384; asm volatile("" : "+s"(kq));
                      EpiUQ E{cst, qb};
                      run_stage<EpiUQ>(lds, t, lo, 6, 6, cqs, (const bf16_t*)(ws + O_WCUQ), M, kq, E, head, dep, need, nullptr, x, wave_s); lo += 36; ++k; }
                    { int kkv = 256; asm volatile("" : "+s"(kkv));
                      EpiUKV E{cst, krb, a.in[7], a.in[36], csc, kb, vb};
                      run_stage<EpiUKV>(lds, t, lo, 8, 8, ckvs, (const bf16_t*)(ws + O_WCUKV), MALL, kkv, E, head, dep, need, nullptr, x, wave_s); lo += 64; ++k; }
                } else {
                    constexpr int nkv = l == 3 ? 16 : 4; constexpr int ntn = (1024 + 2 * nkv * 64) / 256;
                    const bf16_t* Bt = (const bf16_t*)(ws + (l == 0 ? O_WAQKV : l == 1 ? O_WBQKV : O_WDQKV));
                    float* ok = a.out + (l == 0 ? OUT_AK : l == 1 ? OUT_BK : OUT_DK); float* ov = a.out + (l == 0 ? OUT_AV : l == 1 ? OUT_BV : OUT_DV);
                    const float* qg = l == 0 ? a.in[22] : l == 1 ? a.in[27] : a.in[39]; const float* kg = l == 0 ? a.in[23] : l == 1 ? a.in[28] : a.in[40];
                    EpiQKV E{stats, bl, nkv, l < 2 ? 1 : 0, qg, kg, cshd, qb, kb, vb, ok, ov};
                    run_stage<EpiQKV>(lds, t, lo, ntn, 6, xs, Bt, M, D, E, head, dep, need, nullptr, x, wave_s); lo += ntn * 6; ++k;
                }
            }
#undef STAGE_ADV
        }
        return did;
}
template <int PH> DI void run_all(const Args& a, LAS unsigned char* lds, int wave_s, unsigned& nbar) {
    if constexpr (PH < 12) {
        if (a.ph_lo <= PH && PH < a.ph_hi) {
            const bool did = run_phase<PH>(a, lds, wave_s);
#if 0
            { constexpr bool rep = (PH >= 4 && PH != 8 && (PH & 1) == 0 && (REP_MASK & 4)) || (PH == 2 && (REP_MASK & 32)) || (PH == 1 && (REP_MASK & 64));
              if constexpr (rep) { __syncthreads(); (void)run_phase<PH>(a, lds, wave_s); } }
#endif
            if (did && PH + 1 < a.ph_hi) { const int tid = wave_s * 64 + (int)__builtin_amdgcn_mbcnt_hi(~0u, __builtin_amdgcn_mbcnt_lo(~0u, 0u)); grid_bar((unsigned*)(a.ws + O_CTL), (volatile LAS unsigned*)(lds + RING_BYTES + 320), tid); }
        }
        run_all<PH + 1>(a, lds, wave_s, nbar);
    }
}
__global__ void __launch_bounds__(NTHR, 2) mega(Args a) {
    extern __shared__ __attribute__((aligned(16))) unsigned char lds_raw[];
    LAS unsigned char* lds = (LAS unsigned char*)lds_raw;
    if (a.ph_hi < 0) { cg::grid_group grid = cg::this_grid(); grid.sync(); }
    const int wave_s = __builtin_amdgcn_readfirstlane(threadIdx.x >> 6);
    unsigned nbar = 0;
    if (threadIdx.x < 64) ((LAS unsigned*)(lds + RING_BYTES))[threadIdx.x + 64] = 0u;
    __syncthreads();
    if (threadIdx.x == 0) (void)xb_add((unsigned*)(a.ws + O_CTL) + XB_XCNT(xb_xcc_id()), 1u);
    run_all<0>(a, lds, wave_s, nbar);
}

constexpr int N_PHASES = 12;
extern "C" void kernel_launch(void* const* d_in, const int* in_sizes, int n_in, void* d_out, int out_size, void* d_ws, size_t ws_size, hipStream_t stream) {
    static int grid = 0;
    if (grid == 0) {
        if (n_in != 43 || ws_size < WS_NEED || out_size != 26345472) { fprintf(stderr, "kernel_launch: unexpected problem shape (n_in %d, out %d, ws %zu need %zu)\n", n_in, out_size, ws_size, (size_t)WS_NEED); grid = -1; return; }
        int dev = 0, cus = 0, per_cu = 0;
        hipGetDevice(&dev); hipDeviceGetAttribute(&cus, hipDeviceAttributeMultiprocessorCount, dev);
        if (hipFuncSetAttribute((const void*)mega, hipFuncAttributeMaxDynamicSharedMemorySize, LDS_BYTES) != hipSuccess) { fprintf(stderr, "kernel_launch: hipFuncSetAttribute failed\n"); grid = -1; return; }
        if (hipOccupancyMaxActiveBlocksPerMultiprocessor(&per_cu, (const void*)mega, NTHR, LDS_BYTES) != hipSuccess || per_cu < 1) { fprintf(stderr, "kernel_launch: occupancy query says %d\n", per_cu); per_cu = 1; }
        (void)hipGetLastError();
        grid = cus * 1;
        if (grid <= 0) grid = 256;
    }
    if (grid < 0) return;
    if (hipMemsetAsync((char*)d_ws + O_CTL, 0, CTL_BYTES, stream) != hipSuccess) { fprintf(stderr, "kernel_launch: memset failed\n"); return; }
    Args a{};
    for (int i = 0; i < 43; ++i) a.in[i] = (const float*)d_in[i];
    a.out = (float*)d_out; a.ws = (unsigned char*)d_ws; a.ph_lo = 0; a.ph_hi = N_PHASES;
    void* args[] = {&a};
    hipError_t e = hipLaunchCooperativeKernel((const void*)mega, dim3(grid), dim3(NTHR), args, LDS_BYTES, stream);
    if (e != hipSuccess) fprintf(stderr, "kernel_launch: cooperative launch failed: %s (grid %d)\n", hipGetErrorString(e), grid);
}
```

```cpp
#include <hip/hip_runtime.h>
#include <hip/hip_cooperative_groups.h>
#include <cstdio>
#include <cstdint>
namespace cg = cooperative_groups;
namespace pg8 {
#define PG8_LAS __attribute__((address_space(3)))
typedef unsigned short bf16_t;
typedef short bf16x8 __attribute__((ext_vector_type(8)));
typedef float f32x4 __attribute__((ext_vector_type(4)));
typedef unsigned u32x4 __attribute__((ext_vector_type(4)));
constexpr int BM = 256, BK = 64, HALF = 128, HTB = HALF * BK * 2  , STAGE_BYTES = 8 * HTB, NXCD = 8, WGM = 8;

__host__ __device__ __forceinline__ int lds_byte(int r, int c) { const int st = (r >> 4) * 2 + (c >> 5), rr = r & 15, cc = c & 31, ob = rr * 64 + cc * 2; return st * 1024 + (ob ^ (((ob >> 9) & 1) << 5)); }
__host__ __device__ __forceinline__ void stage_rc(int b, int& R, int& C) { const int st = b / 1024, sb = b % 1024, swz = sb ^ (((sb >> 9) & 1) << 5); R = (st >> 1) * 16 + swz / 64; C = (st & 1) * 32 + (swz % 64) / 2; }
__host__ __device__ __forceinline__ int perm32(int rho) { const int n = rho >> 4, i = rho & 15; return 8 * (i >> 2) + 4 * n + (i & 3); }

struct Unit { int pm, pn; };
struct Gemm { const bf16_t* A; const bf16_t* Bt; int M, N, K; };

struct StaticOrder {
    int nM, nN, nwg, G, c;
    __host__ __device__ void init(int M, int N, int G_, int c_) { nM = M / BM; nN = N / BM; nwg = nM * nN; G = G_; c = c_; }
    __host__ __device__ bool next(int i, Unit& u) const {
        const long L = (long)i * G + c; if (L >= nwg) return false;
        int wgid = (int)L; { const int q = nwg / NXCD, r = nwg % NXCD, xcd = wgid % NXCD, off = wgid / NXCD; wgid = (xcd < r ? xcd * (q + 1) : r * (q + 1) + (xcd - r) * q) + off; }
        const int nig = WGM * nN, gid = wgid / nig, fm = gid * WGM, gsz = (nM - fm) < WGM ? (nM - fm) : WGM;
        u.pm = fm + ((wgid % nig) % gsz); u.pn = (wgid % nig) / gsz; return true;
    }
    __device__ __forceinline__ void a_ready(const Unit&) const {}
    __device__ __forceinline__ void done(const Unit&) const {}
};

__device__ __forceinline__ unsigned cvt_pk_bf16(float lo, float hi) { unsigned r; asm volatile("v_cvt_pk_bf16_f32 %0, %1, %2" : "=v"(r) : "v"(lo), "v"(hi)); return r; }
template <class Epi, class Sched, bool ALIGN_EPI = false, bool SP2 = false>
__device__ __forceinline__ void gemm_phase(PG8_LAS unsigned char* lds, const Gemm g, const Sched S, const Epi E, int tid_in) {
    int tid_ = tid_in; asm volatile("" : "+v"(tid_));
    const int tid = tid_, wid = __builtin_amdgcn_readfirstlane(tid >> 6), lane = tid & 63, wr = wid >> 2, wc = wid & 3, fr = lane & 15, fq = lane >> 4;
    const int K = g.K, nt = K / BK;
    unsigned voffA[2], voffB[2];
#pragma unroll
    for (int i = 0; i < 2; ++i) { int R, C; stage_rc(tid * 16 + i * 8192, R, C); const int Rb = Epi::PERM ? ((R & ~31) + perm32(R & 31)) : R;
        voffA[i] = (unsigned)(R * K + C) * 2u; voffB[i] = (unsigned)(Rb * K + C) * 2u; }
    const size_t kstep = (size_t)(BK * 2);
    const size_t hstep = (size_t)HALF * K * 2;
    const size_t tstep = 2 * hstep;
    const unsigned ldsw = (unsigned)wid * 1024u;
    const int aoff = lds_byte(wr * 64 + fr, fq * 8), boff = lds_byte(wc * 32 + fr, fq * 8);
#define PG8_SA(b, h) (((b) * 2 + (h)) * HTB)
#define PG8_SB(b, h) ((4 + (b) * 2 + (h)) * HTB)
#define PG8_STAGE(bufoff, gbase, voff) do { _Pragma("unroll") for (int _i = 0; _i < 2; ++_i) \
        __builtin_amdgcn_global_load_lds((const unsigned*)((const char*)(gbase) + (voff)[_i]), (PG8_LAS unsigned*)(lds + (bufoff) + ldsw + _i * 8192), 16, 0, 0); } while (0)
#define PG8_LDA(dst, b, h) do { _Pragma("unroll") for (int m = 0; m < 4; ++m) _Pragma("unroll") for (int k = 0; k < 2; ++k) dst[m][k] = *(const PG8_LAS bf16x8*)(lds + PG8_SA(b, h) + aoff + m * 2048 + k * 1024); } while (0)
#define PG8_LDB(dst, b, h) do { _Pragma("unroll") for (int n = 0; n < 2; ++n) _Pragma("unroll") for (int k = 0; k < 2; ++k) dst[n][k] = *(const PG8_LAS bf16x8*)(lds + PG8_SB(b, h) + boff + n * 2048 + k * 1024); } while (0)
#define PG8_MMA(ai, bj, At, Bt) do { __builtin_amdgcn_s_setprio(1); _Pragma("unroll") for (int m = 0; m < 4; ++m) _Pragma("unroll") for (int n = 0; n < 2; ++n) _Pragma("unroll") for (int k = 0; k < 2; ++k) \
        acc[ai][bj][m][n] = __builtin_amdgcn_mfma_f32_16x16x32_bf16(Bt[n][k], At[m][k], acc[ai][bj][m][n], 0, 0, 0); __builtin_amdgcn_s_setprio(0); } while (0)
#define PG8_WAIT_V(n) asm volatile("s_waitcnt vmcnt(" #n ")" ::: "memory")
#define PG8_WAIT_L(n) asm volatile("s_waitcnt lgkmcnt(" #n ")" ::: "memory")
#define PG8_BAR __builtin_amdgcn_s_barrier()
#define PG8_SCHED __builtin_amdgcn_sched_barrier(0)
    Unit cur, nxt; int ui = 0;
    if (!S.next(0, cur)) return;
    f32x4 acc[2][2][4][2];
#pragma unroll
    for (int a = 0; a < 2; ++a)
#pragma unroll
        for (int b = 0; b < 2; ++b)
#pragma unroll
            for (int m = 0; m < 4; ++m)
#pragma unroll
                for (int n = 0; n < 2; ++n) acc[a][b][m][n] = (f32x4){0.f, 0.f, 0.f, 0.f};
    bf16x8 At[4][2], B0[2][2], B1[2][2];
    const char* cA = (const char*)g.A + (size_t)cur.pm * tstep; const char* cB = (const char*)g.Bt + (size_t)cur.pn * tstep;
    S.a_ready(cur);
    if constexpr (SP2) {
        PG8_STAGE(PG8_SB(0, 0), cB, voffB); PG8_STAGE(PG8_SB(0, 1), cB + hstep, voffB); PG8_STAGE(PG8_SA(0, 0), cA, voffA); PG8_STAGE(PG8_SA(0, 1), cA + hstep, voffA);
        if (wr == 1) PG8_BAR;
        PG8_WAIT_V(2); PG8_BAR;
        PG8_STAGE(PG8_SB(1, 0), cB + kstep, voffB); PG8_STAGE(PG8_SA(1, 0), cA + kstep, voffA); PG8_STAGE(PG8_SB(1, 1), cB + hstep + kstep, voffB);
        PG8_WAIT_V(6); PG8_BAR;
    } else {
        PG8_STAGE(PG8_SB(0, 0), cB, voffB); PG8_STAGE(PG8_SA(0, 0), cA, voffA); PG8_STAGE(PG8_SB(0, 1), cB + hstep, voffB); PG8_STAGE(PG8_SA(0, 1), cA + hstep, voffA);
        if (wr == 1) PG8_BAR;
        PG8_WAIT_V(4); PG8_BAR;
        PG8_STAGE(PG8_SB(1, 0), cB + kstep, voffB); PG8_STAGE(PG8_SA(1, 0), cA + kstep, voffA); PG8_STAGE(PG8_SB(1, 1), cB + hstep + kstep, voffB);
        PG8_WAIT_V(6); PG8_BAR;
    }
    for (;;) {
        const bool has_next = S.next(ui + 1, nxt);
        const char* nA = has_next ? (const char*)g.A + (size_t)nxt.pm * tstep : cA; const char* nB = has_next ? (const char*)g.Bt + (size_t)nxt.pn * tstep : cB;
        for (int t = 0; t < nt; t += 2) {
            const bool last = (t == nt - 2);
            const char* a1 = cA + (size_t)(t + 1) * kstep;
            const char* a2 = last ? nA : cA + (size_t)(t + 2) * kstep; const char* b2 = last ? nB : cB + (size_t)(t + 2) * kstep;
            const char* a3 = a2 + kstep; const char* b3 = b2 + kstep;
            if (last && has_next) S.a_ready(nxt);
            if constexpr (SP2) {
            PG8_LDB(B0, 0, 0); PG8_LDB(B1, 0, 1); PG8_SCHED; PG8_LDA(At, 0, 0); PG8_STAGE(PG8_SA(1, 1), a1 + hstep, voffA);
            PG8_WAIT_V(8); PG8_WAIT_L(0); PG8_BAR; PG8_MMA(0, 0, At, B0); PG8_MMA(0, 1, At, B1); PG8_BAR; PG8_SCHED;
            PG8_LDA(At, 0, 1); PG8_STAGE(PG8_SB(0, 0), b2, voffB); PG8_STAGE(PG8_SB(0, 1), b2 + hstep, voffB); PG8_STAGE(PG8_SA(0, 0), a2, voffA);
            PG8_WAIT_V(8); PG8_WAIT_L(0); PG8_BAR; PG8_MMA(1, 0, At, B0); PG8_MMA(1, 1, At, B1); PG8_BAR; PG8_SCHED;
            PG8_LDB(B0, 1, 0); PG8_LDB(B1, 1, 1); PG8_SCHED; PG8_LDA(At, 1, 0); PG8_STAGE(PG8_SA(0, 1), a2 + hstep, voffA);
            PG8_WAIT_V(8); PG8_WAIT_L(0); PG8_BAR; PG8_MMA(0, 0, At, B0); PG8_MMA(0, 1, At, B1); PG8_BAR; PG8_SCHED;
            PG8_LDA(At, 1, 1); PG8_STAGE(PG8_SB(1, 0), b3, voffB); PG8_STAGE(PG8_SB(1, 1), b3 + hstep, voffB); PG8_STAGE(PG8_SA(1, 0), a3, voffA);
            PG8_WAIT_V(8); PG8_WAIT_L(0); PG8_BAR; PG8_MMA(1, 0, At, B0); PG8_MMA(1, 1, At, B1); PG8_BAR; PG8_SCHED;
            } else {
            PG8_LDB(B0, 0, 0); PG8_SCHED; PG8_LDA(At, 0, 0); PG8_STAGE(PG8_SA(1, 1), a1 + hstep, voffA);
            PG8_WAIT_L(8); PG8_BAR; PG8_WAIT_L(0); PG8_MMA(0, 0, At, B0); PG8_BAR; PG8_SCHED;
            PG8_LDB(B1, 0, 1); PG8_STAGE(PG8_SB(0, 0), b2, voffB);
            PG8_BAR; PG8_WAIT_L(0); PG8_MMA(0, 1, At, B1); PG8_BAR;
            PG8_LDA(At, 0, 1); PG8_STAGE(PG8_SA(0, 0), a2, voffA);
            PG8_BAR; PG8_WAIT_L(0); PG8_MMA(1, 0, At, B0); PG8_BAR; PG8_SCHED;
            PG8_STAGE(PG8_SB(0, 1), b2 + hstep, voffB);
            PG8_WAIT_V(6); PG8_BAR; PG8_MMA(1, 1, At, B1); PG8_BAR;
            PG8_LDB(B0, 1, 0); PG8_SCHED; PG8_LDA(At, 1, 0); PG8_STAGE(PG8_SA(0, 1), a2 + hstep, voffA);
            PG8_WAIT_L(8); PG8_BAR; PG8_WAIT_L(0); PG8_MMA(0, 0, At, B0); PG8_BAR; PG8_SCHED;
            PG8_LDB(B1, 1, 1); PG8_STAGE(PG8_SB(1, 0), b3, voffB);
            PG8_BAR; PG8_WAIT_L(0); PG8_MMA(0, 1, At, B1); PG8_BAR;
            PG8_LDA(At, 1, 1); PG8_STAGE(PG8_SA(1, 0), a3, voffA);
            PG8_BAR; PG8_WAIT_L(0); PG8_MMA(1, 0, At, B0); PG8_BAR; PG8_SCHED;
            PG8_STAGE(PG8_SB(1, 1), b3 + hstep, voffB);
            PG8_WAIT_V(6); PG8_BAR; PG8_MMA(1, 1, At, B1); PG8_BAR;
            }
        }
        if constexpr (ALIGN_EPI) { if (wr == 0) PG8_BAR; }
        if constexpr (!Epi::AFTER_DRAIN) { E(acc, cur, wr, wc, fr, fq); S.done(cur); }
        if (!has_next) break;
#pragma unroll
        for (int a = 0; a < 2; ++a)
#pragma unroll
            for (int b = 0; b < 2; ++b)
#pragma unroll
                for (int m = 0; m < 4; ++m)
#pragma unroll
                    for (int n = 0; n < 2; ++n) acc[a][b][m][n] = (f32x4){0.f, 0.f, 0.f, 0.f};
        cur = nxt; cA = nA; cB = nB; ++ui;
        if constexpr (ALIGN_EPI) { if (wr == 1) PG8_BAR; }
    }
    PG8_WAIT_V(0);
    if constexpr (!ALIGN_EPI) { if (wr == 0) PG8_BAR; }
    PG8_BAR;
    if constexpr (Epi::AFTER_DRAIN) { E.fused(acc, cur, wr, wc, fr, fq, lds, wid, lane); S.done(cur); }
#undef PG8_SA
#undef PG8_SB
#undef PG8_STAGE
#undef PG8_LDA
#undef PG8_LDB
#undef PG8_MMA
#undef PG8_WAIT_V
#undef PG8_WAIT_L
#undef PG8_BAR
#undef PG8_SCHED
}
}
using pg8::bf16_t; using pg8::f32x4; using pg8::u32x4; using pg8::Unit; using pg8::cvt_pk_bf16;
#define LAS __attribute__((address_space(3)))
#define DI __device__ __forceinline__
#define LDS_WAIT() asm volatile("s_waitcnt lgkmcnt(0)" ::: "memory")
typedef float f32x2 __attribute__((ext_vector_type(2)));
typedef unsigned u32x2 __attribute__((ext_vector_type(2)));

constexpr int D = 1024, MP = 4096, MS = 8192, M = 12288, MALL = 16384;
constexpr int DFF = 2816, NGU = 5632;
constexpr float EPS = 1e-6f;
constexpr float LOG2E = 1.4426950408889634f;
constexpr float QSCALE64 = 0.125f * LOG2E;
constexpr float QSCALE96 = 0.10206207261596575f * LOG2E;
constexpr int NWAVES = 8, NTHR = 512;
constexpr int RING_BYTES = 131072, LDS_BYTES = 147456;

constexpr size_t SZ_WGU = (size_t)NGU * D * 2, SZ_WDN = (size_t)D * DFF * 2;
constexpr size_t O_WGU = 0;
constexpr size_t O_WDN = O_WGU + 8 * SZ_WGU;
constexpr size_t O_WAQKV = O_WDN + 8 * SZ_WDN;
constexpr size_t O_WAO = O_WAQKV + 1536ull * 1024 * 2;
constexpr size_t O_WBQKV = O_WAO + 1024ull * 1024 * 2;
constexpr size_t O_WBO = O_WBQKV + 1536ull * 1024 * 2;
constexpr size_t O_WCDN = O_WBO + 1024ull * 1024 * 2;
constexpr size_t O_WCUQ = O_WCDN + 768ull * 1024 * 2;
constexpr size_t O_WCUKV = O_WCUQ + 1536ull * 384 * 2;
constexpr size_t O_WCO = O_WCUKV + 2048ull * 256 * 2;
constexpr size_t O_WDQKV = O_WCO + 1024ull * 1024 * 2;
constexpr size_t O_WDO = O_WDQKV + 3072ull * 1024 * 2;
constexpr size_t O_XS = O_WDO + 1024ull * 1024 * 2;
constexpr size_t O_ACT = O_XS + (size_t)M * D * 2;
constexpr size_t O_Q = O_ACT + (size_t)M * DFF * 2;
constexpr size_t O_K = O_Q + (size_t)M * 1536 * 2;
constexpr size_t O_V = O_K + (size_t)MALL * 1536 * 2;
constexpr size_t O_OB = O_V + (size_t)MALL * 1024 * 2;
constexpr size_t O_CQS = O_OB + (size_t)M * D * 2;
constexpr size_t O_CKVS = O_CQS + (size_t)M * 384 * 2;
constexpr size_t O_KR = O_CKVS + (size_t)MALL * 256 * 2;
constexpr size_t O_CACHE = O_KR + (size_t)M * 32 * 4;
constexpr size_t O_STATS = O_CACHE + (4ull * 1048576 + 2ull * 4194304) * 2;
constexpr size_t O_CSTATS = O_STATS + (size_t)M * 16 * 4;
constexpr size_t O_MODP = O_CSTATS + (size_t)M * 24 * 4;
constexpr size_t O_MOD = O_MODP + 4ull * 8 * 9 * 9216 * 4;
constexpr size_t O_GS = O_MOD + 4ull * 9 * 9216 * 4;
constexpr size_t O_SHA = O_GS + 4ull * 3 * 9 * 1024 * 4;
constexpr size_t O_BIAS = O_SHA + 12ull * 256 * 1024 * 2;
constexpr size_t O_CSHD = O_BIAS + 12ull * 9 * NGU * 4;
constexpr size_t O_CSC = O_CSHD + 1024ull * 32 * 8;
constexpr size_t O_CTL = O_CSC + 1024ull * 16 * 8;
constexpr size_t WS_NEED = O_CTL + 262144;

constexpr size_t OUT_AK = 12582912, OUT_AV = 13631488, OUT_BK = 14680064, OUT_BV = 15728640, OUT_CKV = 16777216, OUT_CKR = 17825792, OUT_DK = 17956864, OUT_DV = 22151168;

struct Args { const float* in[43]; float* out; unsigned char* ws; int ph_lo, ph_hi; };

DI float bf2f(unsigned short u) { return __builtin_bit_cast(float, (unsigned)u << 16); }
DI float bflo(unsigned w) { return __builtin_bit_cast(float, w << 16); }
DI float bfhi(unsigned w) { return __builtin_bit_cast(float, w & 0xffff0000u); }
DI int mrow_of_tile(int pm) { return pm < 16 ? 0 : 1 + ((pm - 16) >> 2); }
DI float wave_sum(float v) {
#pragma unroll
    for (int o = 1; o < 64; o <<= 1) v += __shfl_xor(v, o);
    return v;
}
DI float sum4(f32x4 a) { return (a.x + a.y) + (a.z + a.w); }
DI float sq4(f32x4 a) { return (a.x * a.x + a.y * a.y) + (a.z * a.z + a.w * a.w); }
DI float row_rs(const float* stats, int row) {
    const f32x4* s = (const f32x4*)(stats + (size_t)row * 16);
    const float t = (sum4(s[0]) + sum4(s[1])) + (sum4(s[2]) + sum4(s[3]));
    return rsqrtf(t * (1.f / 1024.f) + EPS);
}
#define GAS __attribute__((address_space(1)))
DI void row_rs8(const float* stats, int row0, int fq, float (&rr)[2][4]) {
    f32x4 p[2][4];
#pragma unroll
    for (int ai = 0; ai < 2; ++ai)
#pragma unroll
        for (int m = 0; m < 4; ++m) p[ai][m] = *(const GAS f32x4*)(stats + (size_t)(row0 + ai * 128 + m * 16) * 16 + 4 * fq);
#pragma unroll
    for (int ai = 0; ai < 2; ++ai)
#pragma unroll
        for (int m = 0; m < 4; ++m) { float t = sum4(p[ai][m]); t += __shfl_xor(t, 16); t += __shfl_xor(t, 32); rr[ai][m] = rsqrtf(t * (1.f / 1024.f) + EPS); }
}
DI float silu_f(float a) { return a * __builtin_amdgcn_rcpf(1.f + __builtin_amdgcn_exp2f(-a * LOG2E)); }
DI u32x4 pack8(f32x4 a, f32x4 b) { u32x4 w; w.x = cvt_pk_bf16(a.x, a.y); w.y = cvt_pk_bf16(a.z, a.w); w.z = cvt_pk_bf16(b.x, b.y); w.w = cvt_pk_bf16(b.z, b.w); return w; }

struct EpiBias {
    static constexpr bool PERM = true, AFTER_DRAIN = false;
    float* bias;
    DI void operator()(const f32x4 (&acc)[2][2][4][2], const Unit& u, int wr, int wc, int fr, int fq) const {
        int pm_ = u.pm, pn_ = u.pn; asm volatile("" : "+s"(pm_), "+s"(pn_), "+s"(wr), "+s"(wc)); asm volatile("" : "+v"(fr), "+v"(fq));
        if (wr == 0 && fr < 9) {
#pragma unroll
            for (int bj = 0; bj < 2; ++bj) { float* p = bias + (size_t)fr * NGU + pn_ * 256 + bj * 128 + wc * 32 + 8 * fq;
                *(f32x4*)p = acc[0][bj][0][0]; *(f32x4*)(p + 4) = acc[0][bj][0][1]; }
        }
    }
};
struct EpiGU {
    static constexpr bool PERM = true, AFTER_DRAIN = false;
    const float* stats; const float* bias; bf16_t* act;
    DI void operator()(const f32x4 (&acc)[2][2][4][2], const Unit& u, int wr, int wc, int fr, int fq) const {
        int pm_ = u.pm, pn_ = u.pn; asm volatile("" : "+s"(pm_), "+s"(pn_), "+s"(wr), "+s"(wc)); asm volatile("" : "+v"(fr), "+v"(fq));
        const int mr = mrow_of_tile(pm_);
        const float* bp = bias + (size_t)mr * NGU + pn_ * 256 + wc * 32 + 8 * fq;
        const f32x4 ba0 = *(const GAS f32x4*)bp, ba1 = *(const GAS f32x4*)(bp + 4), bu0 = *(const GAS f32x4*)(bp + 128), bu1 = *(const GAS f32x4*)(bp + 132);
        float rr8[2][4]; row_rs8(stats, pm_ * 256 + wr * 64 + fr, fq, rr8);
#pragma unroll
        for (int ai = 0; ai < 2; ++ai)
#pragma unroll
            for (int m = 0; m < 4; ++m) {
                __builtin_amdgcn_sched_barrier(0);
                const int row = pm_ * 256 + ai * 128 + wr * 64 + m * 16 + fr;
                const float rr = rr8[ai][m];
                const f32x4 a0 = acc[ai][0][m][0] * rr + ba0, a1 = acc[ai][0][m][1] * rr + ba1, u0 = acc[ai][1][m][0] * rr + bu0, u1 = acc[ai][1][m][1] * rr + bu1;
                f32x4 r0, r1;
#pragma unroll
                for (int j = 0; j < 4; ++j) { r0[j] = silu_f(a0[j]) * u0[j]; r1[j] = silu_f(a1[j]) * u1[j]; }
                *(GAS u32x4*)(act + (size_t)row * DFF + pn_ * 128 + wc * 32 + 8 * fq) = pack8(r0, r1);
            }
    }
};
struct EpiRes {
    static constexpr bool PERM = true, AFTER_DRAIN = false;
    float* X; const float* gate; const float* gsn; bf16_t* xs; float* stats; const float* Xr0; const float* Xr1; float gscale; float pad_;
    DI void operator()(const f32x4 (&acc)[2][2][4][2], const Unit& u, int wr, int wc, int fr, int fq) const {
        int pm_ = u.pm, pn_ = u.pn; asm volatile("" : "+s"(pm_), "+s"(pn_), "+s"(wr), "+s"(wc)); asm volatile("" : "+v"(fr), "+v"(fq));
        const int mr = mrow_of_tile(pm_);
        const int c0 = pn_ * 256 + wc * 32 + 8 * fq;
        f32x4 g[2][2], s[2][2];
#pragma unroll
        for (int bj = 0; bj < 2; ++bj) { const float* gp = gate + (size_t)mr * 9216 + c0 + bj * 128; g[bj][0] = *(const f32x4*)gp * gscale; g[bj][1] = *(const f32x4*)(gp + 4) * gscale;
            if (gsn) { const float* sp = gsn + (size_t)mr * 1024 + c0 + bj * 128; s[bj][0] = *(const f32x4*)sp; s[bj][1] = *(const f32x4*)(sp + 4); } else { s[bj][0] = s[bj][1] = (f32x4){0.f, 0.f, 0.f, 0.f}; } }
        f32x4 xc[2][2], xn[2][2];
#define RES_LOAD(DST, I) do { const int row_ = pm_ * 256 + ((I) >> 2) * 128 + wr * 64 + ((I) & 3) * 16 + fr; const float* xb_ = (row_ < MP ? Xr0 : Xr1) + (size_t)row_ * D + c0; \
            _Pragma("unroll") for (int bj = 0; bj < 2; ++bj) { DST[bj][0] = *(const GAS f32x4*)(xb_ + bj * 128); DST[bj][1] = *(const GAS f32x4*)(xb_ + bj * 128 + 4); } } while (0)
        RES_LOAD(xc, 0);
#pragma unroll
        for (int i = 0; i < 8; ++i) {
            const int ai = i >> 2, m = i & 3;
            if (i < 7) RES_LOAD(xn, i + 1);
            const int row = pm_ * 256 + ai * 128 + wr * 64 + m * 16 + fr;
            float ss = 0.f;
#pragma unroll
            for (int bj = 0; bj < 2; ++bj) {
                float* xp = X + (size_t)row * D + c0 + bj * 128;
                f32x4 x0 = xc[bj][0], x1 = xc[bj][1];
                x0 += g[bj][0] * acc[ai][bj][m][0]; x1 += g[bj][1] * acc[ai][bj][m][1];
                *(GAS f32x4*)xp = x0; *(GAS f32x4*)(xp + 4) = x1;
                ss += sq4(x0) + sq4(x1);
                if (gsn) *(GAS u32x4*)(xs + (size_t)row * D + c0 + bj * 128) = pack8(x0 * s[bj][0], x1 * s[bj][1]);
            }
            ss += __shfl_xor(ss, 16); ss += __shfl_xor(ss, 32);
            if (gsn && fq == 0) *(GAS float*)(stats + (size_t)row * 16 + pn_ * 4 + wc) = ss;
#pragma unroll
            for (int bj = 0; bj < 2; ++bj) { xc[bj][0] = xn[bj][0]; xc[bj][1] = xn[bj][1]; }
        }
#undef RES_LOAD
    }
};
struct EpiQKV {
    static constexpr bool PERM = true, AFTER_DRAIN = false;
    const float* stats; const float* bias; int nkv; int rope; const float* qg; const float* kg; const float* cs;
    bf16_t* q; bf16_t* k; bf16_t* v; float* ok; float* ov;
    DI void operator()(const f32x4 (&acc)[2][2][4][2], const Unit& u, int wr, int wc, int fr, int fq) const {
        int pm_ = u.pm, pn_ = u.pn; asm volatile("" : "+s"(pm_), "+s"(pn_), "+s"(wr), "+s"(wc)); asm volatile("" : "+v"(fr), "+v"(fq));
        const int mr = mrow_of_tile(pm_);
        const int slot = 4 * pn_ + wc;
        const int type = slot < 16 ? 0 : (slot < 16 + nkv ? 1 : 2);
        const int hh = type == 0 ? slot : (type == 1 ? slot - 16 : slot - 16 - nkv);
        const int kvw = nkv * 64;
        f32x4 b[2][2], gn[2][2];
#pragma unroll
        for (int bj = 0; bj < 2; ++bj) { const float* bp = bias + (size_t)mr * NGU + pn_ * 256 + bj * 128 + wc * 32 + 8 * fq; b[bj][0] = *(const f32x4*)bp; b[bj][1] = *(const f32x4*)(bp + 4);
            const float* gp = (type == 0 ? qg : kg) + 32 * bj + 8 * fq; gn[bj][0] = *(const f32x4*)gp; gn[bj][1] = *(const f32x4*)(gp + 4); }
        float rr8[2][4]; row_rs8(stats, pm_ * 256 + wr * 64 + fr, fq, rr8);
#pragma unroll
        for (int ai = 0; ai < 2; ++ai)
#pragma unroll
            for (int m = 0; m < 4; ++m) {
                __builtin_amdgcn_sched_barrier(0);
                const int row = pm_ * 256 + ai * 128 + wr * 64 + m * 16 + fr;
                const float rr = rr8[ai][m];
                f32x4 v0[2], v1[2];
#pragma unroll
                for (int bj = 0; bj < 2; ++bj) { v0[bj] = acc[ai][bj][m][0] * rr + b[bj][0]; v1[bj] = acc[ai][bj][m][1] * rr + b[bj][1]; }
                if (type < 2) {
                    float ss = (sq4(v0[0]) + sq4(v1[0])) + (sq4(v0[1]) + sq4(v1[1]));
                    ss += __shfl_xor(ss, 16); ss += __shfl_xor(ss, 32);
                    const float rinv = rsqrtf(ss * (1.f / 64.f) + EPS);
#pragma unroll
                    for (int bj = 0; bj < 2; ++bj) { v0[bj] = v0[bj] * rinv * gn[bj][0]; v1[bj] = v1[bj] * rinv * gn[bj][1]; }
                    if (type == 1 && row < MP) {
#pragma unroll
                        for (int bj = 0; bj < 2; ++bj) { float* op = ok + (size_t)row * kvw + hh * 64 + 32 * bj + 8 * fq; *(f32x4*)op = v0[bj]; *(f32x4*)(op + 4) = v1[bj]; }
                    }
                    if (rope && row >= MP) {
                        const int pos = (row - MP) & 1023;
#pragma unroll
                        for (int bj = 0; bj < 2; ++bj) {
                            const float* cp = cs + ((size_t)pos * 32 + 16 * bj + 4 * fq) * 2;
                            const f32x4 t0 = *(const f32x4*)cp, t1 = *(const f32x4*)(cp + 4);
                            f32x4 a = v0[bj], c = v1[bj];
                            v0[bj] = (f32x4){a.x * t0.x - a.y * t0.y, a.x * t0.y + a.y * t0.x, a.z * t0.z - a.w * t0.w, a.z * t0.w + a.w * t0.z};
                            v1[bj] = (f32x4){c.x * t1.x - c.y * t1.y, c.x * t1.y + c.y * t1.x, c.z * t1.z - c.w * t1.w, c.z * t1.w + c.w * t1.z};
                        }
                    }
                    if (type == 0) {
#pragma unroll
                        for (int bj = 0; bj < 2; ++bj) *(u32x4*)(q + (size_t)row * 1024 + hh * 64 + 32 * bj + 8 * fq) = pack8(v0[bj] * QSCALE64, v1[bj] * QSCALE64);
                    } else {
#pragma unroll
                        for (int bj = 0; bj < 2; ++bj) *(u32x4*)(k + (size_t)row * kvw + hh * 64 + 32 * bj + 8 * fq) = pack8(v0[bj], v1[bj]);
                    }
                } else {
#pragma unroll
                    for (int bj = 0; bj < 2; ++bj) { *(u32x4*)(v + (size_t)row * kvw + hh * 64 + 32 * bj + 8 * fq) = pack8(v0[bj], v1[bj]);
                        if (row < MP) { float* op = ov + (size_t)row * kvw + hh * 64 + 32 * bj + 8 * fq; *(f32x4*)op = v0[bj]; *(f32x4*)(op + 4) = v1[bj]; } }
                }
            }
    }
};
struct EpiCDown {
    static constexpr bool PERM = true, AFTER_DRAIN = false;
    const float* stats; const float* bias; const float* qln; const float* kvln; bf16_t* cqs; bf16_t* ckvs; float* krb; float* cst; float* okv; float* okr;
    DI void operator()(const f32x4 (&acc)[2][2][4][2], const Unit& u, int wr, int wc, int fr, int fq) const {
        int pm_ = u.pm, pn_ = u.pn; asm volatile("" : "+s"(pm_), "+s"(pn_), "+s"(wr), "+s"(wc)); asm volatile("" : "+v"(fr), "+v"(fq));
        const int mr = mrow_of_tile(pm_);
        float rr8[2][4]; row_rs8(stats, pm_ * 256 + wr * 64 + fr, fq, rr8);
#pragma unroll
        for (int bj = 0; bj < 2; ++bj) {
            const int c0 = pn_ * 256 + bj * 128 + wc * 32 + 8 * fq;
            if (c0 >= 672) continue;
            const float* bp = bias + (size_t)mr * NGU + c0;
            const f32x4 b0 = *(const f32x4*)bp, b1 = *(const f32x4*)(bp + 4);
            const int reg = c0 < 384 ? 0 : (c0 < 640 ? 1 : 2);
            f32x4 g0 = (f32x4){1.f, 1.f, 1.f, 1.f}, g1 = g0;
            if (reg == 0) { g0 = *(const f32x4*)(qln + c0); g1 = *(const f32x4*)(qln + c0 + 4); }
            if (reg == 1) { g0 = *(const f32x4*)(kvln + c0 - 384); g1 = *(const f32x4*)(kvln + c0 - 380); }
#pragma unroll
            for (int ai = 0; ai < 2; ++ai)
#pragma unroll
                for (int m = 0; m < 4; ++m) {
                    __builtin_amdgcn_sched_barrier(0);
                const int row = pm_ * 256 + ai * 128 + wr * 64 + m * 16 + fr;
                    const float rr = rr8[ai][m];
                    const f32x4 v0 = acc[ai][bj][m][0] * rr + b0, v1 = acc[ai][bj][m][1] * rr + b1;
                    float ss = sq4(v0) + sq4(v1);
                    ss += __shfl_xor(ss, 16); ss += __shfl_xor(ss, 32);
                    if (fq == 0) cst[(size_t)row * 24 + pn_ * 8 + bj * 4 + wc] = ss;
                    if (reg == 0) *(u32x4*)(cqs + (size_t)row * 384 + c0) = pack8(v0 * g0, v1 * g1);
                    else if (reg == 1) { const f32x4 w0 = v0 * g0, w1 = v1 * g1; *(u32x4*)(ckvs + (size_t)row * 256 + c0 - 384) = pack8(w0, w1);
                        if (row < MP) { float* op = okv + (size_t)row * 256 + c0 - 384; *(f32x4*)op = w0; *(f32x4*)(op + 4) = w1; } }
                    else { float* kp = krb + (size_t)row * 32 + c0 - 640; *(f32x4*)kp = v0; *(f32x4*)(kp + 4) = v1;
                        if (row < MP) { float* op = okr + (size_t)row * 32 + c0 - 640; *(f32x4*)op = v0; *(f32x4*)(op + 4) = v1; } }
                }
        }
    }
};
DI float cst_sum(const float* cst, int row, int lo, int cnt4) {
    const f32x4* s = (const f32x4*)(cst + (size_t)row * 24 + lo); float t = 0.f;
    for (int i = 0; i < cnt4; ++i) t += sum4(s[i]);
    return t;
}
struct EpiUQ {
    static constexpr bool PERM = true, AFTER_DRAIN = false;
    const float* cst; bf16_t* qraw;
    DI void operator()(const f32x4 (&acc)[2][2][4][2], const Unit& u, int wr, int wc, int fr, int fq) const {
        int pm_ = u.pm, pn_ = u.pn; asm volatile("" : "+s"(pm_), "+s"(pn_), "+s"(wr), "+s"(wc)); asm volatile("" : "+v"(fr), "+v"(fq));
#pragma unroll
        for (int ai = 0; ai < 2; ++ai)
#pragma unroll
            for (int m = 0; m < 4; ++m) {
                __builtin_amdgcn_sched_barrier(0);
                const int row = pm_ * 256 + ai * 128 + wr * 64 + m * 16 + fr;
                const float rq = rsqrtf(cst_sum(cst, row, 0, 3) * (1.f / 384.f) + EPS);
#pragma unroll
                for (int bj = 0; bj < 2; ++bj) *(u32x4*)(qraw + (size_t)row * 1536 + pn_ * 256 + bj * 128 + wc * 32 + 8 * fq) = pack8(acc[ai][bj][m][0] * rq, acc[ai][bj][m][1] * rq);
            }
    }
};
struct EpiUKV {
    static constexpr bool PERM = true, AFTER_DRAIN = false;
    const float* cst; const float* krb; const float* krc; const float* kg; const float* cs; bf16_t* kk; bf16_t* vv;
    DI void operator()(const f32x4 (&acc)[2][2][4][2], const Unit& u, int wr, int wc, int fr, int fq) const {
        int pm_ = u.pm, pn_ = u.pn; asm volatile("" : "+s"(pm_), "+s"(pn_), "+s"(wr), "+s"(wc)); asm volatile("" : "+v"(fr), "+v"(fq));
        const int slot = 4 * pn_ + wc, h = slot >> 1, part = slot & 1;
        f32x4 gn[2][2], gr0, gr1;
#pragma unroll
        for (int bj = 0; bj < 2; ++bj) { gn[bj][0] = *(const f32x4*)(kg + 32 * bj + 8 * fq); gn[bj][1] = *(const f32x4*)(kg + 32 * bj + 8 * fq + 4); }
        gr0 = *(const f32x4*)(kg + 64 + 8 * fq); gr1 = *(const f32x4*)(kg + 68 + 8 * fq);
#pragma unroll
        for (int ai = 0; ai < 2; ++ai)
#pragma unroll
            for (int m = 0; m < 4; ++m) {
                __builtin_amdgcn_sched_barrier(0);
                const int row = pm_ * 256 + ai * 128 + wr * 64 + m * 16 + fr;
                const float rkv = row < M ? rsqrtf(cst_sum(cst, row, 12, 2) * (1.f / 256.f) + EPS) : 1.f;
                f32x4 v0[2], v1[2];
#pragma unroll
                for (int bj = 0; bj < 2; ++bj) { v0[bj] = acc[ai][bj][m][0] * rkv; v1[bj] = acc[ai][bj][m][1] * rkv; }
                if (part == 1) {
#pragma unroll
                    for (int bj = 0; bj < 2; ++bj) *(u32x4*)(vv + (size_t)row * 1024 + h * 64 + 32 * bj + 8 * fq) = pack8(v0[bj], v1[bj]);
                } else {
                    const float* kp = (row < M ? krb + (size_t)row * 32 : krc + (size_t)(row - M) * 32) + 8 * fq;
                    f32x4 k0 = *(const f32x4*)kp, k1 = *(const f32x4*)(kp + 4);
                    float ss = (sq4(v0[0]) + sq4(v1[0])) + (sq4(v0[1]) + sq4(v1[1])) + (sq4(k0) + sq4(k1));
                    ss += __shfl_xor(ss, 16); ss += __shfl_xor(ss, 32);
                    const float rk = rsqrtf(ss * (1.f / 96.f) + EPS);
#pragma unroll
                    for (int bj = 0; bj < 2; ++bj) *(u32x4*)(kk + (size_t)row * 1536 + h * 96 + 32 * bj + 8 * fq) = pack8(v0[bj] * rk * gn[bj][0], v1[bj] * rk * gn[bj][1]);
                    k0 = k0 * rk * gr0; k1 = k1 * rk * gr1;
                    if (row >= MP && row < M) {
                        const int pos = (row - MP) & 1023;
                        const float* cp = cs + ((size_t)pos * 16 + 4 * fq) * 2;
                        const f32x4 t0 = *(const f32x4*)cp, t1 = *(const f32x4*)(cp + 4);
                        const f32x4 a = k0, c = k1;
                        k0 = (f32x4){a.x * t0.x - a.y * t0.y, a.x * t0.y + a.y * t0.x, a.z * t0.z - a.w * t0.w, a.z * t0.w + a.w * t0.z};
                        k1 = (f32x4){c.x * t1.x - c.y * t1.y, c.x * t1.y + c.y * t1.x, c.z * t1.z - c.w * t1.w, c.z * t1.w + c.w * t1.z};
                    }
                    *(u32x4*)(kk + (size_t)row * 1536 + h * 96 + 64 + 8 * fq) = pack8(k0, k1);
                }
            }
    }
};
DI void transpose_item(const float* W, int K, int N, bf16_t* WT, int perm, int item, int lane) {
    const int nblk = N / 32, kb = item / nblk, nb = item % nblk, k0 = 64 * kb, n0 = 32 * nb;
    const int kg = lane >> 3, ng = lane & 7;
    const float* src = W + (size_t)(k0 + 8 * kg) * N + n0 + 4 * ng;
    f32x4 v[8];
#pragma unroll
    for (int kk = 0; kk < 8; ++kk) v[kk] = *(const f32x4*)(src + (size_t)kk * N);
    int r0 = n0;
    if (perm == 1) { const int j = n0 < DFF ? n0 : n0 - DFF; r0 = 256 * (j >> 7) + (n0 < DFF ? 0 : 128) + (j & 127); }
    else if (perm == 2) { const int slot = n0 >> 6, d = n0 & 63; r0 = 256 * (slot >> 2) + 128 * (d >> 5) + 32 * (slot & 3); }
    bf16_t* dst = WT + (size_t)(r0 + 4 * ng) * K + k0 + 8 * kg;
#pragma unroll
    for (int j = 0; j < 4; ++j) { u32x4 o; o.x = cvt_pk_bf16(v[0][j], v[1][j]); o.y = cvt_pk_bf16(v[2][j], v[3][j]); o.z = cvt_pk_bf16(v[4][j], v[5][j]); o.w = cvt_pk_bf16(v[6][j], v[7][j]);
        *(u32x4*)(dst + (size_t)j * K) = o; }
}
DI void cvt_range(const float* src, bf16_t* dst, size_t n8, size_t gt, size_t ngt) {
    for (size_t i = gt; i < n8; i += ngt) { const f32x4 a = *(const f32x4*)(src + i * 8), b = *(const f32x4*)(src + i * 8 + 4); *(u32x4*)(dst + i * 8) = pack8(a, b); }
}
DI float modval(const float* modp, const float* modb, int l, int r, int n) {
    float t = modb[l * 9216 + n];
#pragma unroll
    for (int kc = 0; kc < 8; ++kc) t += modp[((size_t)(l * 8 + kc) * 9 + r) * 9216 + n];
    return t;
}
DI void sincos_d(double ang, float& c, float& s) {
    const double k = __builtin_rint(ang * 0.15915494309189535);
    const double r = ang - k * 6.283185307179586;
    const double x2 = r * r;
    double P = 1.0, Q = 1.0;
#pragma unroll
    for (int i = 14; i >= 1; --i) { P = 1.0 - P * x2 * (1.0 / (double)((2 * i) * (2 * i + 1))); Q = 1.0 - Q * x2 * (1.0 / (double)((2 * i - 1) * (2 * i))); }
    s = (float)(r * P); c = (float)Q;
}

template <int DK>
DI void akey(const float (&q)[DK], float (&o)[64], float& m, float& l, const bf16_t* kp, const bf16_t* vp, float bias, bool valid) {
    float s = bias;
#pragma unroll
    for (int c = 0; c < DK / 8; ++c) { const u32x4 w = ((const u32x4*)kp)[c];
        s += q[8 * c] * bflo(w.x) + q[8 * c + 1] * bfhi(w.x) + q[8 * c + 2] * bflo(w.y) + q[8 * c + 3] * bfhi(w.y) + q[8 * c + 4] * bflo(w.z) + q[8 * c + 5] * bfhi(w.z) + q[8 * c + 6] * bflo(w.w) + q[8 * c + 7] * bfhi(w.w); }
    if (valid) {
        const float mn = fmaxf(m, s), al = __builtin_amdgcn_exp2f(m - mn), p = __builtin_amdgcn_exp2f(s - mn);
        l = l * al + p; m = mn;
#pragma unroll
        for (int c = 0; c < 8; ++c) { const u32x4 w = ((const u32x4*)vp)[c];
            o[8 * c] = o[8 * c] * al + p * bflo(w.x); o[8 * c + 1] = o[8 * c + 1] * al + p * bfhi(w.x); o[8 * c + 2] = o[8 * c + 2] * al + p * bflo(w.y); o[8 * c + 3] = o[8 * c + 3] * al + p * bfhi(w.y);
            o[8 * c + 4] = o[8 * c + 4] * al + p * bflo(w.z); o[8 * c + 5] = o[8 * c + 5] * al + p * bfhi(w.z); o[8 * c + 6] = o[8 * c + 6] * al + p * bflo(w.w); o[8 * c + 7] = o[8 * c + 7] * al + p * bfhi(w.w); }
    }
}
template <int MODE>
DI void attn_naive(const bf16_t* Q, const bf16_t* K, const bf16_t* V, const bf16_t* CK, const bf16_t* CV, bf16_t* O,
                   const float* sink, const float* rpb, const float* cqg, const float* csc, int gw, int ngw, int lane) {
    constexpr int DK = MODE == 2 ? 96 : 64;
    constexpr int G = (MODE <= 1) ? 4 : 1;
    constexpr int KS = MODE <= 1 ? 256 : (MODE == 2 ? 1536 : 1024);
    constexpr int VS = MODE <= 1 ? 256 : 1024;
    constexpr int QS = MODE == 2 ? 1536 : 1024;
    for (int it = gw; it < 3072; it += ngw) {
        const int h = it & 15, rbi = it >> 4, rb = rbi < 128 ? 64 + rbi : rbi - 128;
        const int row = rb * 64 + lane, kvh = h / G;
        const bool samp = rb >= 64;
        const int b = samp ? (rb - 64) >> 4 : rb >> 2, p0 = samp ? ((rb - 64) & 15) * 64 : 0, qpos = p0 + lane;
        float q[DK], o[64];
        { const u32x4* qp = (const u32x4*)(Q + (size_t)row * QS + h * DK);
#pragma unroll
          for (int c = 0; c < DK / 8; ++c) { const u32x4 w = qp[c]; q[8 * c] = bflo(w.x); q[8 * c + 1] = bfhi(w.x); q[8 * c + 2] = bflo(w.y); q[8 * c + 3] = bfhi(w.y); q[8 * c + 4] = bflo(w.z); q[8 * c + 5] = bfhi(w.z); q[8 * c + 6] = bflo(w.w); q[8 * c + 7] = bfhi(w.w); } }
        if (MODE == 2) {
            float ss = 0.f;
#pragma unroll
            for (int d = 0; d < DK; ++d) ss += q[d] * q[d];
            const float rinv = rsqrtf(ss * (1.f / 96.f) + EPS);
#pragma unroll
            for (int d = 0; d < DK; ++d) q[d] = q[d] * rinv * cqg[d];
            if (samp) {
#pragma unroll
                for (int i = 0; i < 16; ++i) { const f32x2 t = *(const f32x2*)(csc + ((size_t)qpos * 16 + i) * 2); const float x0 = q[64 + 2 * i], x1 = q[65 + 2 * i]; q[64 + 2 * i] = x0 * t.x - x1 * t.y; q[65 + 2 * i] = x0 * t.y + x1 * t.x; }
            }
#pragma unroll
            for (int d = 0; d < DK; ++d) q[d] *= QSCALE96;
        }
#pragma unroll
        for (int d = 0; d < 64; ++d) o[d] = 0.f;
        float m = -1e30f, l = 0.f;
        if (MODE == 0) { m = sink[h] * LOG2E; l = 1.f; }
        if (!samp) {
            const bf16_t* kb = K + (size_t)(b * 256) * KS + kvh * DK; const bf16_t* vb = V + (size_t)(b * 256) * VS + kvh * 64;
            for (int j = 0; j < 256; ++j) akey<DK>(q, o, m, l, kb + (size_t)j * KS, vb + (size_t)j * VS, 0.f, true);
        } else {
            const bf16_t* kb = K + (size_t)(MP + b * 1024) * KS + kvh * DK; const bf16_t* vb = V + (size_t)(MP + b * 1024) * VS + kvh * 64;
            if (MODE == 0) {
                const int lo = p0 - 128 < 0 ? 0 : p0 - 128, hi = p0 + 192 > 1024 ? 1024 : p0 + 192;
                for (int j = lo; j < hi; ++j) { const int dd = qpos - j; akey<DK>(q, o, m, l, kb + (size_t)j * KS, vb + (size_t)j * VS, 0.f, dd <= 128 && dd >= -128); }
            } else if (MODE == 3) {
                const int r = p0 >> 6, rs = r - 4 < 0 ? 0 : (r - 4 > 8 ? 8 : r - 4);
                const int cs0 = lane - 8 < 0 ? 0 : (lane - 8 > 48 ? 48 : lane - 8);
                for (int j = rs * 64; j < rs * 64 + 512; ++j) { const int kr = j >> 6, kc = j & 63; const bool valid = kc >= cs0 && kc < cs0 + 16;
                    const float bias = valid ? rpb[(h * 15 + (kr - r + 7)) * 31 + (kc - lane + 15)] * LOG2E : 0.f;
                    akey<DK>(q, o, m, l, kb + (size_t)j * KS, vb + (size_t)j * VS, bias, valid); }
            } else {
                for (int j = 0; j < 1024; ++j) akey<DK>(q, o, m, l, kb + (size_t)j * KS, vb + (size_t)j * VS, 0.f, true);
            }
            const bf16_t* ckb = CK + (size_t)(b * 512) * KS + kvh * DK; const bf16_t* cvb = CV + (size_t)(b * 512) * VS + kvh * 64;
            for (int j = 0; j < 512; ++j) akey<DK>(q, o, m, l, ckb + (size_t)j * KS, cvb + (size_t)j * VS, 0.f, true);
        }
        const float il = 1.f / l;
        u32x4* op = (u32x4*)(O + (size_t)row * 1024 + h * 64);
#pragma unroll
        for (int c = 0; c < 8; ++c) { u32x4 w; w.x = cvt_pk_bf16(o[8 * c] * il, o[8 * c + 1] * il); w.y = cvt_pk_bf16(o[8 * c + 2] * il, o[8 * c + 3] * il); w.z = cvt_pk_bf16(o[8 * c + 4] * il, o[8 * c + 5] * il); w.w = cvt_pk_bf16(o[8 * c + 6] * il, o[8 * c + 7] * il); op[c] = w; }
    }
}
typedef short bf16x8_t __attribute__((ext_vector_type(8)));
typedef float f32x16 __attribute__((ext_vector_type(16)));
typedef __bf16 bf16x2_t __attribute__((ext_vector_type(2)));
typedef short s16x4 __attribute__((ext_vector_type(4)));
typedef short v4i16_t __attribute__((ext_vector_type(4)));
DI unsigned cvtpk(float lo, float hi) { f32x2 v = {lo, hi}; bf16x2_t b = __builtin_convertvector(v, bf16x2_t); return __builtin_bit_cast(unsigned, b); }
DI s16x4 vtr(LAS unsigned char* p) { return __builtin_bit_cast(s16x4, __builtin_amdgcn_ds_read_tr16_b64_v4i16((LAS v4i16_t*)p)); }
DI int crow16(int i, int hh) { return (i & 3) + 8 * (i >> 2) + 4 * hh; }
DI int clampi(int v, int lo, int hi) { return v < lo ? lo : (v > hi ? hi : v); }

template <int MODE>
DI void attn_mfma(const bf16_t* Q, const bf16_t* K, const bf16_t* V, const bf16_t* CK, const bf16_t* CV, bf16_t* O,
                  const float* sink, const float* rpb, const float* cqg, const float* csc, LAS unsigned char* lds, int bx, int G, int tid, int wave) {
    constexpr int DK = MODE == 2 ? 96 : 64;
    constexpr int KS = MODE <= 1 ? 256 : (MODE == 2 ? 1536 : 1024);
    constexpr int VS = MODE <= 1 ? 256 : 1024;
    constexpr int QS = MODE == 2 ? 1536 : 1024;
    constexpr int KROWB = DK * 2 + 16, VROWB = 144, KBUF = 64 * KROWB, VBUF = 64 * VROWB;
    constexpr int OFF_V = 2 * KBUF, OFF_RPB = OFF_V + 2 * VBUF;
    constexpr int NS = DK / 16;
    const int lane = tid & 63, r = lane & 31, hh = lane >> 5;
    const int i16 = lane & 15, tq = i16 >> 2, tp = i16 & 3, tblk = (lane >> 4) & 1;
    LAS float* rpbL = (LAS float*)(lds + OFF_RPB);
    for (int item = bx; item < 768; item += G) {
        const bool samp = item < 512;
        int b, kvh, p0, head, q0;
        if (MODE <= 1) {
            if (samp) { b = item >> 6; kvh = (item >> 4) & 3; p0 = (item & 15) * 64; } else { const int j = item - 512; b = j >> 4; kvh = (j >> 2) & 3; p0 = (j & 3) * 64; }
            head = kvh * 4 + (wave >> 1); q0 = p0 + 32 * (wave & 1);
        } else {
            if (samp) { b = item >> 6; head = (item >> 2) & 15; p0 = (item & 3) * 256; } else { const int j = item - 512; b = j >> 4; head = j & 15; p0 = 0; }
            kvh = head; q0 = p0 + 32 * wave;
        }
        const int rowbase = samp ? MP + b * 1024 : b * 256;
        const int qrow = rowbase + q0 + r, qpos = q0 + r;
        bf16x8_t qf[NS];
        if (MODE != 2) {
#pragma unroll
            for (int s = 0; s < NS; ++s) qf[s] = *(const GAS bf16x8_t*)(Q + (size_t)qrow * QS + head * DK + 16 * s + 8 * hh);
        } else {
            float v[NS][8]; float ss = 0.f;
#pragma unroll
            for (int s = 0; s < NS; ++s) { const u32x4 w = *(const GAS u32x4*)(Q + (size_t)qrow * QS + head * DK + 16 * s + 8 * hh);
                v[s][0] = bflo(w.x); v[s][1] = bfhi(w.x); v[s][2] = bflo(w.y); v[s][3] = bfhi(w.y); v[s][4] = bflo(w.z); v[s][5] = bfhi(w.z); v[s][6] = bflo(w.w); v[s][7] = bfhi(w.w);
#pragma unroll
                for (int j = 0; j < 8; ++j) ss += v[s][j] * v[s][j]; }
            ss += __shfl_xor(ss, 32);
            const float rinv = rsqrtf(ss * (1.f / 96.f) + EPS) ;
#pragma unroll
            for (int s = 0; s < NS; ++s) { const f32x4 g0 = *(const f32x4*)(cqg + 16 * s + 8 * hh), g1 = *(const f32x4*)(cqg + 16 * s + 8 * hh + 4);
#pragma unroll
                for (int j = 0; j < 4; ++j) { v[s][j] *= rinv * g0[j]; v[s][4 + j] *= rinv * g1[j]; }
                if (s >= 4 && samp) {
                    const float* cp = csc + ((size_t)qpos * 16 + 8 * (s - 4) + 4 * hh) * 2;
                    const f32x4 t0 = *(const f32x4*)cp, t1 = *(const f32x4*)(cp + 4);
                    float a0 = v[s][0], a1 = v[s][1]; v[s][0] = a0 * t0.x - a1 * t0.y; v[s][1] = a0 * t0.y + a1 * t0.x;
                    a0 = v[s][2]; a1 = v[s][3]; v[s][2] = a0 * t0.z - a1 * t0.w; v[s][3] = a0 * t0.w + a1 * t0.z;
                    a0 = v[s][4]; a1 = v[s][5]; v[s][4] = a0 * t1.x - a1 * t1.y; v[s][5] = a0 * t1.y + a1 * t1.x;
                    a0 = v[s][6]; a1 = v[s][7]; v[s][6] = a0 * t1.z - a1 * t1.w; v[s][7] = a0 * t1.w + a1 * t1.z;
                }
                u32x4 w; w.x = cvtpk(v[s][0] * QSCALE96, v[s][1] * QSCALE96); w.y = cvtpk(v[s][2] * QSCALE96, v[s][3] * QSCALE96); w.z = cvtpk(v[s][4] * QSCALE96, v[s][5] * QSCALE96); w.w = cvtpk(v[s][6] * QSCALE96, v[s][7] * QSCALE96);
                qf[s] = __builtin_bit_cast(bf16x8_t, w); }
        }
        int nlat, lat0, klo = 0, ncache = samp ? 8 : 0;
        if (!samp) { lat0 = rowbase; nlat = 4; }
        else if (MODE == 0) { const int lo = p0 - 128 < 0 ? 0 : p0 - 128, hi = p0 + 192 > 1024 ? 1024 : p0 + 192; lat0 = rowbase + lo; nlat = (hi - lo) >> 6; klo = lo; }
        else if (MODE == 3) { const int r0 = p0 >> 6, lo = clampi(r0 - 4, 0, 8), hi = clampi(r0 - 1, 0, 8) + 8; lat0 = rowbase + lo * 64; nlat = hi - lo; klo = lo; }
        else { lat0 = rowbase; nlat = 16; }
        const int nt = nlat + ncache;
        if (MODE == 3) { for (int i = tid; i < 465; i += NTHR) rpbL[i] = *(const GAS float*)(rpb + head * 465 + i) * LOG2E; }
        u32x4 kst0, kst1, vst;
        const int kkey0 = DK == 64 ? tid >> 3 : tid / 12, kc0 = DK == 64 ? tid & 7 : tid % 12;
        const int kkey1 = (tid + 512) / 12, kc1 = (tid + 512) % 12;
        const int vkey = tid >> 3, vc = tid & 7;
#define ATT_LOAD(T) do { const int t_ = (T); const bf16_t* kp_; const bf16_t* vp_; \
            if (t_ < nlat) { kp_ = K + (size_t)(lat0 + 64 * t_) * KS + kvh * DK; vp_ = V + (size_t)(lat0 + 64 * t_) * VS + kvh * 64; } \
            else { kp_ = CK + (size_t)(b * 512 + 64 * (t_ - nlat)) * KS + kvh * DK; vp_ = CV + (size_t)(b * 512 + 64 * (t_ - nlat)) * VS + kvh * 64; } \
            kst0 = *(const GAS u32x4*)(kp_ + (size_t)kkey0 * KS + kc0 * 8); \
            if (DK == 96 && tid < 256) kst1 = *(const GAS u32x4*)(kp_ + (size_t)kkey1 * KS + kc1 * 8); \
            vst = *(const GAS u32x4*)(vp_ + (size_t)vkey * VS + vc * 8); } while (0)
#define ATT_STORE(B) do { LAS unsigned char* kb_ = lds + (B) * KBUF; LAS unsigned char* vb_ = lds + OFF_V + (B) * VBUF; \
            *(LAS u32x4*)(kb_ + kkey0 * KROWB + kc0 * 16) = kst0; \
            if (DK == 96 && tid < 256) *(LAS u32x4*)(kb_ + kkey1 * KROWB + kc1 * 16) = kst1; \
            *(LAS u32x4*)(vb_ + vkey * VROWB + vc * 16) = vst; } while (0)
        ATT_LOAD(0); ATT_STORE(0);
        __syncthreads();
        f32x16 o0, o1;
#pragma unroll
        for (int i = 0; i < 16; ++i) { o0[i] = 0.f; o1[i] = 0.f; }
        float l = 0.f;
        if (MODE == 0) l = hh == 0 ? __builtin_amdgcn_exp2f(sink[head] * LOG2E) : 0.f;
        const int rq = (q0 >> 6), qc = (q0 & 63) + r, rsw = clampi(rq - 4, 0, 8), cs0 = clampi(qc - 8, 0, 48);
        for (int t = 0; t < nt; ++t) {
            if (t + 1 < nt) ATT_LOAD(t + 1);
            LAS unsigned char* kbuf = lds + (t & 1) * KBUF; LAS unsigned char* vbuf = lds + OFF_V + (t & 1) * VBUF;
            const bool lat = samp && t < nlat;
            bool active = true;
            if (MODE == 3 && lat) { const int kr = klo + t; active = kr >= rsw && kr < rsw + 8; }
            if (active) {
                f32x16 s0, s1;
#pragma unroll
                for (int i = 0; i < 16; ++i) { s0[i] = 0.f; s1[i] = 0.f; }
#pragma unroll
                for (int s = 0; s < NS; ++s) {
                    const bf16x8_t k0 = *(LAS bf16x8_t*)(kbuf + r * KROWB + (16 * s + 8 * hh) * 2);
                    const bf16x8_t k1 = *(LAS bf16x8_t*)(kbuf + (32 + r) * KROWB + (16 * s + 8 * hh) * 2);
                    s0 = __builtin_amdgcn_mfma_f32_32x32x16_bf16(k0, qf[s], s0, 0, 0, 0);
                    s1 = __builtin_amdgcn_mfma_f32_32x32x16_bf16(k1, qf[s], s1, 0, 0, 0);
                }
                if (MODE == 0 && lat) {
                    const int kbase = klo + 64 * t;
                    if (kbase + 63 - q0 > 128 || q0 + 31 - kbase > 128) {
#pragma unroll
                        for (int i = 0; i < 16; ++i) { const int d0 = qpos - (kbase + crow16(i, hh)), d1 = d0 - 32;
                            if (d0 > 128 || d0 < -128) s0[i] = -INFINITY; if (d1 > 128 || d1 < -128) s1[i] = -INFINITY; }
                    }
                }
                if (MODE == 3 && lat) {
                    const int kr = klo + t; const LAS float* rp = rpbL + (kr - rq + 7) * 31 + 15 - qc;
#pragma unroll
                    for (int i = 0; i < 16; ++i) { const int kc = crow16(i, hh), kc2 = kc + 32;
                        const bool v0 = kc >= cs0 && kc < cs0 + 16, v1 = kc2 >= cs0 && kc2 < cs0 + 16;
                        const float b0 = rp[clampi(kc, qc - 15, qc + 15)], b1 = rp[clampi(kc2, qc - 15, qc + 15)];
                        s0[i] = v0 ? s0[i] + b0 : -INFINITY; s1[i] = v1 ? s1[i] + b1 : -INFINITY; }
                }
                float rs = 0.f;
#pragma unroll
                for (int i = 0; i < 16; ++i) { s0[i] = __builtin_amdgcn_exp2f(s0[i]); s1[i] = __builtin_amdgcn_exp2f(s1[i]); rs += s0[i] + s1[i]; }
                l += rs;
#pragma unroll
                for (int kb = 0; kb < 2; ++kb)
#pragma unroll
                    for (int s2 = 0; s2 < 2; ++s2) {
                        u32x4 pw;
                        if (kb == 0) { pw.x = cvtpk(s0[8 * s2], s0[8 * s2 + 1]); pw.y = cvtpk(s0[8 * s2 + 2], s0[8 * s2 + 3]); pw.z = cvtpk(s0[8 * s2 + 4], s0[8 * s2 + 5]); pw.w = cvtpk(s0[8 * s2 + 6], s0[8 * s2 + 7]); }
                        else { pw.x = cvtpk(s1[8 * s2], s1[8 * s2 + 1]); pw.y = cvtpk(s1[8 * s2 + 2], s1[8 * s2 + 3]); pw.z = cvtpk(s1[8 * s2 + 4], s1[8 * s2 + 5]); pw.w = cvtpk(s1[8 * s2 + 6], s1[8 * s2 + 7]); }
                        const bf16x8_t pb = __builtin_bit_cast(bf16x8_t, pw);
                        LAS unsigned char* vp = vbuf + (32 * kb + 16 * s2 + 4 * hh + tq) * VROWB + (16 * tblk + 4 * tp) * 2;
                        const s16x4 a0 = vtr(vp), a1 = vtr(vp + 8 * VROWB), c0 = vtr(vp + 64), c1 = vtr(vp + 8 * VROWB + 64);
                        const bf16x8_t vf0 = __builtin_shufflevector(a0, a1, 0, 1, 2, 3, 4, 5, 6, 7), vf1 = __builtin_shufflevector(c0, c1, 0, 1, 2, 3, 4, 5, 6, 7);
                        o0 = __builtin_amdgcn_mfma_f32_32x32x16_bf16(vf0, pb, o0, 0, 0, 0);
                        o1 = __builtin_amdgcn_mfma_f32_32x32x16_bf16(vf1, pb, o1, 0, 0, 0);
                    }
            }
            if (t + 1 < nt) ATT_STORE((t + 1) & 1);
            __syncthreads();
        }
#undef ATT_LOAD
#undef ATT_STORE
        l += __shfl_xor(l, 32);
        const float il = 1.f / l;
        bf16_t* op = O + (size_t)qrow * 1024 + head * 64 + 4 * hh;
#pragma unroll
        for (int g = 0; g < 4; ++g) {
            u32x2 w0, w1;
            w0.x = cvtpk(o0[4 * g] * il, o0[4 * g + 1] * il); w0.y = cvtpk(o0[4 * g + 2] * il, o0[4 * g + 3] * il);
            w1.x = cvtpk(o1[4 * g] * il, o1[4 * g + 1] * il); w1.y = cvtpk(o1[4 * g + 2] * il, o1[4 * g + 3] * il);
            *(GAS u32x2*)(op + 8 * g) = w0; *(GAS u32x2*)(op + 32 + 8 * g) = w1;
        }
    }
}
__constant__ double q4[4] = {1.0, 0.5623413251903491, 0.31622776601683794, 0.1778279410038923};
__constant__ double p10[4] = {1.0, 0.1, 0.01, 0.001};
#ifndef SITE_MASK
#define SITE_MASK 0xff
#endif
#define SITE(n) (((SITE_MASK) >> (n)) & 1)
#ifndef REP_MASK
#define REP_MASK 0
#endif
#ifndef NAIVE_ATTN
#define NAIVE_ATTN 0
#endif
#if NAIVE_ATTN
#define ATTN attn_naive
#define ATTN_TAIL gw, ngw, lane
#else
#define ATTN attn_mfma
#define ATTN_TAIL lds, bx, G, tid, wave
#endif
#ifndef NOATTN
#define NOATTN 0
#endif
#ifndef NOP0
#define NOP0 0
#endif
#define PGALIGN true
#define PGSP2 true
#define XB_TMO      128
#define XB_XCNT(j)  (256  + 64 * (j))
#define XB_XSUB(j)  (1280 + 64 * (j))
#define XB_XGEN(j)  (2304 + 64 * (j))
#define XB_TOP      3328
#define XB_TOPGEN   3392
#define XB_SPIN_CAP (1u << 20)
DI unsigned xb_ld(unsigned* p) { return __hip_atomic_load(p, __ATOMIC_RELAXED, __HIP_MEMORY_SCOPE_AGENT); }
DI unsigned xb_add(unsigned* p, unsigned v) { return __hip_atomic_fetch_add(p, v, __ATOMIC_RELAXED, __HIP_MEMORY_SCOPE_AGENT); }
DI unsigned xb_xcc_id() { return (unsigned)__builtin_amdgcn_s_getreg((3 << 11) | 20) & 0xFu; }
#define XB_SPIN(cond, bar) do { unsigned _sp = 0; while (cond) { __builtin_amdgcn_s_sleep(1); \
    if ((++_sp & 255u) == 0u) { if (xb_ld(&(bar)[XB_TMO])) break; if (_sp > XB_SPIN_CAP) { atomicAdd(&(bar)[XB_TMO], 1u); break; } } } } while (0)
DI void xcd_barrier_complete(unsigned* bar, unsigned x, unsigned G, unsigned& nloc, unsigned& nx) {
    unsigned sum, cnt, mine, sp = 0u;
    for (;;) {
        sum = 0u; cnt = 0u; mine = 0u;
#pragma unroll
        for (unsigned j = 0; j < 16; ++j) { const unsigned c = xb_ld(&bar[XB_XCNT(j)]); sum += c; cnt += (c > 0u) ? 1u : 0u; mine = (j == x) ? c : mine; }
        if (sum == G) break;
        __builtin_amdgcn_s_sleep(1);
        if ((++sp & 255u) == 0u) { if (xb_ld(&bar[XB_TMO])) break; if (sp > XB_SPIN_CAP) { atomicAdd(&bar[XB_TMO], 1u); break; } }
    }
    nloc = mine > 0u ? mine : 1u; nx = cnt > 0u ? cnt : 1u;
}
DI void grid_bar(unsigned* bar, volatile LAS unsigned* st, int tid) {
    asm volatile("s_waitcnt vmcnt(0)" ::: "memory");
    __syncthreads();
    if (tid == 0) {
        __builtin_amdgcn_s_waitcnt(0);
        const unsigned x = xb_xcc_id();
        unsigned nloc = st[0], nx = st[1];
        if (nloc == 0u) { xcd_barrier_complete(bar, x, gridDim.x, nloc, nx); st[0] = nloc; st[1] = nx; }
        const unsigned old = xb_add(&bar[XB_XSUB(x)], 1u);
        const unsigned gen = old / nloc;
        if (old + 1u == (gen + 1u) * nloc) {
            __builtin_amdgcn_fence(__ATOMIC_RELEASE, "agent");
            asm volatile("s_waitcnt vmcnt(0)" ::: "memory");
            const unsigned og = xb_add(&bar[XB_TOP], 1u);
            const unsigned tg = og / nx;
            if (og + 1u == (tg + 1u) * nx) xb_add(&bar[XB_TOPGEN], 1u);
            else XB_SPIN(xb_ld(&bar[XB_TOPGEN]) == tg, bar);
            __builtin_amdgcn_fence(__ATOMIC_ACQUIRE, "agent");
            xb_add(&bar[XB_XGEN(x)], 1u);
            asm volatile("s_waitcnt vmcnt(0)" ::: "memory");
        } else {
            XB_SPIN(xb_ld(&bar[XB_XGEN(x)]) == gen, bar);
            __builtin_amdgcn_fence(__ATOMIC_ACQUIRE, "agent");
            asm volatile("s_waitcnt vmcnt(0)" ::: "memory");
        }
    }
    __syncthreads();
}
constexpr size_t CTL_HEAD_OFF = 16384, CTL_CNT_OFF = 32768, CTL_BYTES = 262144;
struct QueueOrder {
    unsigned* head; const unsigned* dep; unsigned need; unsigned* pub;
    int lo, hi, ntn, gsz, x, first; int* carry; volatile LAS int* mail; int wave, lane;
    DI void decode(int t, pg8::Unit& u) const { const int j = t - lo, per = gsz * ntn, g = j / per, r = j - g * per; u.pn = r / gsz; u.pm = x + 8 * (g * gsz + (r - u.pn * gsz)); }
    DI bool next(int i, pg8::Unit& u) const {
        int t = first, ready = 1;
        if (i != 0) {
            if (i == 1 && wave == 0) {
                int tt = 0;
                if (lane == 0) tt = (int)__hip_atomic_fetch_add(head, 1u, __ATOMIC_RELAXED, __HIP_MEMORY_SCOPE_AGENT);
                tt = __builtin_amdgcn_readfirstlane(tt);
                int rd = 1;
                if (tt < hi && dep) { pg8::Unit v; decode(tt, v); if (v.pm < 48) rd = __builtin_amdgcn_readfirstlane((int)(__hip_atomic_load(dep + 16 * v.pm, __ATOMIC_RELAXED, __HIP_MEMORY_SCOPE_AGENT) >= need)); }
                if (lane == 0) { mail[0] = tt; mail[1] = rd; mail[2] = 0; }
                asm volatile("s_waitcnt vmcnt(0) lgkmcnt(0)" ::: "memory");
            }
            asm volatile("" ::: "memory"); __builtin_amdgcn_s_barrier(); asm volatile("" ::: "memory");
            t = __builtin_amdgcn_readfirstlane(mail[0]); ready = __builtin_amdgcn_readfirstlane(mail[1]);
            *carry = t;
            if (t >= hi || !ready) { if (wave == 0 && lane == 0) mail[2] = 1; return false; }
            decode(t, u); return true;
        }
        decode(t, u); return true;
    }
    DI void a_ready(const pg8::Unit& u) const {
        if (dep && u.pm < 48) {
            if (wave == 0) {
                unsigned sp = 0;
                while ((unsigned)__builtin_amdgcn_readfirstlane((int)__hip_atomic_load(dep + 16 * u.pm, __ATOMIC_RELAXED, __HIP_MEMORY_SCOPE_AGENT)) < need) { __builtin_amdgcn_s_sleep(2); if (++sp > (1u << 22)) break; }
                __builtin_amdgcn_fence(__ATOMIC_ACQUIRE, "agent");
                asm volatile("s_waitcnt vmcnt(0)" ::: "memory");
            }
            asm volatile("" ::: "memory"); __builtin_amdgcn_s_barrier(); asm volatile("" ::: "memory");
        }
    }
    DI void done(const pg8::Unit& u) const {
        const int holding = __builtin_amdgcn_readfirstlane(mail[2]);
        int tt = 0;
        if (!holding && wave == 0 && lane == 0) tt = (int)__hip_atomic_fetch_add(head, 1u, __ATOMIC_RELAXED, __HIP_MEMORY_SCOPE_AGENT);
        asm volatile("s_waitcnt vmcnt(0)" : "+v"(tt) :: "memory");
        if (pub && lane == 0) (void)__hip_atomic_fetch_add(pub + 16 * u.pm, 1u, __ATOMIC_RELAXED, __HIP_MEMORY_SCOPE_AGENT);
        if (!holding && wave == 0) {
            tt = __builtin_amdgcn_readfirstlane(tt);
            int rd = 1;
            if (tt < hi && dep) { pg8::Unit v; decode(tt, v); if (v.pm < 48) rd = __builtin_amdgcn_readfirstlane((int)(__hip_atomic_load(dep + 16 * v.pm, __ATOMIC_RELAXED, __HIP_MEMORY_SCOPE_AGENT) >= need)); }
            if (lane == 0) { mail[0] = tt; mail[1] = rd; }
            asm volatile("s_waitcnt vmcnt(0) lgkmcnt(0)" ::: "memory");
        }
    }
};
template <class Epi>
DI void run_stage(LAS unsigned char* lds, int& t, int lo, int ntn, int npan, const bf16_t* A, const bf16_t* Bt, int Mrows, int K, const Epi& E,
                  unsigned* head, const unsigned* dep, unsigned need, unsigned* pub, int x, int wave_s) {
    const int hi = lo + ntn * npan;
    while (t >= lo && t < hi) {
        int tid = wave_s * 64 + (int)__builtin_amdgcn_mbcnt_hi(~0u, __builtin_amdgcn_mbcnt_lo(~0u, 0u)); asm volatile("" : "+v"(tid));
        QueueOrder S{head, dep, need, pub, lo, hi, ntn, npan / 2, x, t, &t, (volatile LAS int*)(lds + RING_BYTES + 1024), wave_s, tid & 63};
        pg8::Gemm gg{A, Bt, Mrows, ntn * 256, K};
        pg8::gemm_phase<Epi, QueueOrder, PGALIGN, PGSP2>(lds, gg, S, E, tid);
    }
}
template <int ph> DI bool run_phase(const Args& a, LAS unsigned char* lds, int wave_s) {
        bool did = true;
        int tid = wave_s * 64 + (int)__builtin_amdgcn_mbcnt_hi(~0u, __builtin_amdgcn_mbcnt_lo(~0u, 0u)); asm volatile("" : "+v"(tid));
        int bx = blockIdx.x; asm volatile("" : "+s"(bx));
        const int lane = tid & 63, wave = wave_s;
        const int G = gridDim.x;
        const int gw = bx * NWAVES + wave, ngw = G * NWAVES;
        const size_t gt = (size_t)bx * NTHR + tid, ngt = (size_t)G * NTHR;
    unsigned char* ws = a.ws; asm volatile("" : "+s"(ws));
    float* X = a.out; asm volatile("" : "+s"(X));
    bf16_t* xs = (bf16_t*)(ws + O_XS); bf16_t* act = (bf16_t*)(ws + O_ACT); bf16_t* qb = (bf16_t*)(ws + O_Q); bf16_t* kb = (bf16_t*)(ws + O_K); bf16_t* vb = (bf16_t*)(ws + O_V);
    bf16_t* ob = (bf16_t*)(ws + O_OB); bf16_t* cqs = (bf16_t*)(ws + O_CQS); bf16_t* ckvs = (bf16_t*)(ws + O_CKVS); float* krb = (float*)(ws + O_KR);
    bf16_t* cache = (bf16_t*)(ws + O_CACHE); float* stats = (float*)(ws + O_STATS); float* cst = (float*)(ws + O_CSTATS);
    float* modp = (float*)(ws + O_MODP); float* mod = (float*)(ws + O_MOD); float* gs = (float*)(ws + O_GS); bf16_t* sha = (bf16_t*)(ws + O_SHA); float* bias = (float*)(ws + O_BIAS);
    float* cshd = (float*)(ws + O_CSHD); float* csc = (float*)(ws + O_CSC);

        if (ph == 0 && !NOP0) {
            LAS float* scr = (LAS float*)(lds + wave * 16384);
            constexpr int I_GU = 16 * 176, I_DN = 44 * 32, I_L = 2 * (I_GU + I_DN);
            constexpr int I_AQ = 16 * 48, I_O = 16 * 32, I_CD = 16 * 21, I_CUQ = 6 * 48, I_CUKV = 4 * 64, I_DQ = 16 * 96;
            constexpr int NIT = 4 * I_L + 2 * (I_AQ + I_O) + I_CD + I_CUQ + I_CUKV + I_O + I_DQ + I_O;
#define TR(SRC, KK, NN, PERM, DST, CNT) { if (r < (CNT)) { transpose_item((SRC), (KK), (NN), (bf16_t*)(ws + (DST)), (PERM), r, lane); continue; } r -= (CNT); }
            for (int it = gw; it < NIT; it += ngw) {
                int r = it;
                if (r < 4 * I_L) { const int l = r / I_L; r -= l * I_L;
                    TR(a.in[17] + (size_t)l * D * NGU, D, NGU, 1, O_WGU + (size_t)(2 * l) * SZ_WGU, I_GU)
                    TR(a.in[19] + (size_t)l * D * NGU, D, NGU, 1, O_WGU + (size_t)(2 * l + 1) * SZ_WGU, I_GU)
                    TR(a.in[18] + (size_t)l * DFF * D, DFF, D, 0, O_WDN + (size_t)(2 * l) * SZ_WDN, I_DN)
                    TR(a.in[20] + (size_t)l * DFF * D, DFF, D, 0, O_WDN + (size_t)(2 * l + 1) * SZ_WDN, I_DN)
                    continue; }
                r -= 4 * I_L;
                TR(a.in[21], D, 1536, 2, O_WAQKV, I_AQ)
                TR(a.in[25], D, D, 0, O_WAO, I_O)
                TR(a.in[26], D, 1536, 2, O_WBQKV, I_AQ)
                TR(a.in[29], D, D, 0, O_WBO, I_O)
                TR(a.in[30], D, 672, 0, O_WCDN, I_CD)
                TR(a.in[33], 384, 1536, 0, O_WCUQ, I_CUQ)
                TR(a.in[34], 256, 2048, 2, O_WCUKV, I_CUKV)
                TR(a.in[37], D, D, 0, O_WCO, I_O)
                TR(a.in[38], D, 3072, 2, O_WDQKV, I_DQ)
                TR(a.in[42], D, D, 0, O_WDO, I_O)
            }
#undef TR
            for (int it = gw; it < 4 * 36 * 8; it += ngw) {
                const int l = it / 288, rem = it % 288, nb = rem >> 3, kc = rem & 7, k0 = kc * 128, n0 = nb * 256 + lane * 4;
                for (int idx = lane; idx < 9 * 128; idx += 64) { const int r = idx >> 7, kk = idx & 127; const float c = r == 0 ? a.in[11][k0 + kk] : a.in[10][(r - 1) * D + k0 + kk]; scr[idx] = silu_f(c); }
                LDS_WAIT(); asm volatile("" ::: "memory");
                f32x4 ac[9];
#pragma unroll
                for (int r = 0; r < 9; ++r) ac[r] = (f32x4){0.f, 0.f, 0.f, 0.f};
                const float* wp = a.in[12] + ((size_t)l * D + k0) * 9216 + n0;
#pragma unroll 8
                for (int kk = 0; kk < 128; ++kk) { const f32x4 w = *(const f32x4*)(wp + (size_t)kk * 9216);
#pragma unroll
                    for (int r = 0; r < 9; ++r) ac[r] += w * scr[r * 128 + kk]; }
#pragma unroll
                for (int r = 0; r < 9; ++r) *(f32x4*)(modp + ((size_t)(l * 8 + kc) * 9 + r) * 9216 + n0) = ac[r];
                LDS_WAIT(); asm volatile("" ::: "memory");
            }
            cvt_range(a.in[2], cache, 131072, gt, ngt); cvt_range(a.in[3], cache + 1048576, 131072, gt, ngt);
            cvt_range(a.in[4], cache + 2 * 1048576, 131072, gt, ngt); cvt_range(a.in[5], cache + 3 * 1048576, 131072, gt, ngt);
            cvt_range(a.in[8], cache + 4 * 1048576, 524288, gt, ngt); cvt_range(a.in[9], cache + 8 * 1048576, 524288, gt, ngt);
            cvt_range(a.in[6], ckvs + (size_t)M * 256, 131072, gt, ngt);
            for (size_t i = gt; i < 1024 * 48; i += ngt) {
                const int pos = (int)(i / 48), t = (int)(i % 48);
                double ang; float c, s;
                if (t < 32) { const int ii = t & 15; ang = (double)(t < 16 ? pos >> 6 : pos & 63) * (q4[ii & 3] * p10[ii >> 2]); sincos_d(ang, c, s); cshd[((size_t)pos * 32 + t) * 2] = c; cshd[((size_t)pos * 32 + t) * 2 + 1] = s; }
                else { const int t2 = t - 32, ii = t2 & 7; ang = (double)(t2 < 8 ? pos >> 6 : pos & 63) * (q4[(ii & 1) * 2] * p10[ii >> 1]); sincos_d(ang, c, s); csc[((size_t)pos * 16 + t2) * 2] = c; csc[((size_t)pos * 16 + t2) * 2 + 1] = s; }
            }
        } else if (ph == 1) {
            for (size_t i = gt; i < 4 * 9 * 9216; i += ngt) { const int l = (int)(i / (9 * 9216)), r = (int)((i / 9216) % 9), n = (int)(i % 9216); mod[i] = modval(modp, a.in[13], l, r, n); }
            for (size_t i = gt; i < 4 * 3 * 9 * 1024; i += ngt) {
                const int k = (int)(i & 1023), r = (int)((i >> 10) % 9), nm = (int)((i / 9216) % 3), l = (int)(i / 27648);
                const float g = a.in[14 + nm][l * D + k];
                gs[i] = g * (1.f + modval(modp, a.in[13], l, r, (3 * nm + 1) * 1024 + k));
                const float sh = modval(modp, a.in[13], l, r, (3 * nm) * 1024 + k);
                sha[((size_t)(l * 3 + nm) * 256 + r) * 1024 + k] = (bf16_t)(cvt_pk_bf16(sh, 0.f) & 0xffffu);
            }
        } else if (ph == 2) {
            int off = 0;
            for (int g = 0; g < 12; ++g) {
                const int l = g / 3, nm = g % 3;
                const bf16_t* Bt; int N;
                if (nm != 1) { Bt = (const bf16_t*)(ws + O_WGU + (size_t)(2 * l + (nm == 2)) * SZ_WGU); N = NGU; }
                else if (l == 0) { Bt = (const bf16_t*)(ws + O_WAQKV); N = 1536; } else if (l == 1) { Bt = (const bf16_t*)(ws + O_WBQKV); N = 1536; }
                else if (l == 2) { Bt = (const bf16_t*)(ws + O_WCDN); N = 768; } else { Bt = (const bf16_t*)(ws + O_WDQKV); N = 3072; }
                pg8::Gemm gg{sha + (size_t)g * 256 * 1024, Bt, 256, N, D}; pg8::StaticOrder S; S.init(256, N, G, (bx + G - (off % G)) % G);
                EpiBias E{bias + (size_t)g * 9 * NGU};
                if (SITE(0)) pg8::gemm_phase<EpiBias, pg8::StaticOrder, PGALIGN, PGSP2>(lds, gg, S, E, tid);
                off += N / 256;
            }
            for (int m = gw; m < M; m += ngw) {
                const int mr = mrow_of_tile(m >> 8);
                const f32x4* xr = (const f32x4*)(m < MP ? a.in[0] + (size_t)m * D : a.in[1] + (size_t)(m - MP) * D) + lane; const f32x4* gr = (const f32x4*)(gs + (size_t)mr * 1024) + lane;
                float ss = 0.f;
#pragma unroll
                for (int j = 0; j < 4; ++j) { const f32x4 v = xr[64 * j], g4 = gr[64 * j]; ss += sq4(v); const f32x4 w = v * g4;
                    u32x2 o; o.x = cvt_pk_bf16(w.x, w.y); o.y = cvt_pk_bf16(w.z, w.w); *((u32x2*)(xs + (size_t)m * D) + lane + 64 * j) = o; }
                ss = wave_sum(ss);
                if (lane < 16) stats[(size_t)m * 16 + lane] = lane == 0 ? ss : 0.f;
            }
        } else if ((ph & 1) == 0) {
            constexpr int l = (ph - 4) >> 1;
            if (l == 2) { float* okv = a.out + OUT_CKV;
                for (int m = gw; m < MP; m += ngw) { const float r = rsqrtf(cst_sum(cst, m, 12, 2) * (1.f / 256.f) + EPS); f32x4* p = (f32x4*)(okv + (size_t)m * 256) + lane; *p = *p * r; } }
            if (l == 0) ATTN<0>(qb, kb, vb, cache, cache + 1048576, ob, a.in[24], nullptr, nullptr, nullptr, ATTN_TAIL);
            else if (l == 1) ATTN<1>(qb, kb, vb, cache + 2 * 1048576, cache + 3 * 1048576, ob, nullptr, nullptr, nullptr, nullptr, ATTN_TAIL);
            else if (l == 2) ATTN<2>(qb, kb, vb, kb + (size_t)M * 1536, vb + (size_t)M * 1024, ob, nullptr, nullptr, a.in[35], csc, ATTN_TAIL);
            else ATTN<3>(qb, kb, vb, cache + 4 * 1048576, cache + 8 * 1048576, ob, nullptr, a.in[41], nullptr, nullptr, ATTN_TAIL);
        } else {
            constexpr int sg = (ph - 3) >> 1;
            const int x = (int)(xb_xcc_id() & 7u);
            unsigned* ctl = (unsigned*)(ws + O_CTL);
            unsigned* head = ctl + CTL_HEAD_OFF / 4 + (sg * 8 + x) * 64;
            unsigned* cntb = ctl + CTL_CNT_OFF / 4 + (size_t)(sg * 10) * 64 * 16;
            volatile LAS int* mail = (volatile LAS int*)(lds + RING_BYTES + 1024);
            if (wave == 0) { int tt = 0; if (lane == 0) tt = (int)__hip_atomic_fetch_add(head, 1u, __ATOMIC_RELAXED, __HIP_MEMORY_SCOPE_AGENT); tt = __builtin_amdgcn_readfirstlane(tt); if (lane == 0) mail[0] = tt; }
            __syncthreads();
            int t = __builtin_amdgcn_readfirstlane(mail[0]);
            __syncthreads();
            int lo = 0, k = 0; const unsigned* dep = nullptr; unsigned need = 0;
#define STAGE_ADV(NTN, NPAN) do { lo += (NTN) * (NPAN); dep = cntb + (size_t)k * 64 * 16; need = 8u * (NTN); ++k; } while (0)
            if (sg >= 1) {
                constexpr int l = sg - 1;
                const float* modl = mod + (size_t)l * 9 * 9216;
                { EpiRes E{X, modl + 5 * 1024, gs + (size_t)(l * 3 + 2) * 9 * 1024, xs, stats, X, X, 1.f, 0.f};
                  run_stage<EpiRes>(lds, t, lo, 4, 6, ob, (const bf16_t*)(ws + (l == 0 ? O_WAO : l == 1 ? O_WBO : l == 2 ? O_WCO : O_WDO)), M, D, E, head, dep, need, cntb + (size_t)k * 64 * 16, x, wave_s); STAGE_ADV(4, 6); }
                { EpiGU E{stats, bias + (size_t)(l * 3 + 2) * 9 * NGU, act};
                  run_stage<EpiGU>(lds, t, lo, 22, 6, xs, (const bf16_t*)(ws + O_WGU + (size_t)(2 * l + 1) * SZ_WGU), M, D, E, head, dep, need, cntb + (size_t)k * 64 * 16, x, wave_s); STAGE_ADV(22, 6); }
                { EpiRes E{X, modl + 8 * 1024, l < 3 ? gs + (size_t)((l + 1) * 3) * 9 * 1024 : nullptr, xs, stats, X, X, 0.5f, 0.f};
                  run_stage<EpiRes>(lds, t, lo, 4, 6, act, (const bf16_t*)(ws + O_WDN + (size_t)(2 * l + 1) * SZ_WDN), M, DFF, E, head, dep, need, sg <= 3 ? cntb + (size_t)k * 64 * 16 : nullptr, x, wave_s); STAGE_ADV(4, 6); }
            }
            if (sg <= 3) {
                constexpr int l = sg;
                const float* modl = mod + (size_t)l * 9 * 9216;
                { EpiGU E{stats, bias + (size_t)(l * 3) * 9 * NGU, act};
                  run_stage<EpiGU>(lds, t, lo, 22, 6, xs, (const bf16_t*)(ws + O_WGU + (size_t)(2 * l) * SZ_WGU), M, D, E, head, dep, need, cntb + (size_t)k * 64 * 16, x, wave_s); STAGE_ADV(22, 6); }
                { EpiRes E{X, modl + 2 * 1024, gs + (size_t)(l * 3 + 1) * 9 * 1024, xs, stats, sg == 0 ? a.in[0] : X, sg == 0 ? a.in[1] - (size_t)MP * D : X, 0.5f, 0.f};
                  run_stage<EpiRes>(lds, t, lo, 4, 6, act, (const bf16_t*)(ws + O_WDN + (size_t)(2 * l) * SZ_WDN), M, DFF, E, head, dep, need, cntb + (size_t)k * 64 * 16, x, wave_s); STAGE_ADV(4, 6); }
                const float* bl = bias + (size_t)(l * 3 + 1) * 9 * NGU;
                if (l == 2) {
                    { EpiCDown E{stats, bl, a.in[31], a.in[32], cqs, ckvs, krb, cst, a.out + OUT_CKV, a.out + OUT_CKR};
                      run_stage<EpiCDown>(lds, t, lo, 3, 6, xs, (const bf16_t*)(ws + O_WCDN), M, D, E, head, dep, need, cntb + (size_t)k * 64 * 16, x, wave_s); STAGE_ADV(3, 6); }
                    { int kq = 384; asm volatile("" : "+s"(kq));
                      EpiUQ E{cst, qb};
                      run_stage<EpiUQ>(lds, t, lo, 6, 6, cqs, (const bf16_t*)(ws + O_WCUQ), M, kq, E, head, dep, need, nullptr, x, wave_s); lo += 36; ++k; }
                    { int kkv = 256; asm volatile("" : "+s"(kkv));
                      EpiUKV E{cst, krb, a.in[7], a.in[36], csc, kb, vb};
                      run_stage<EpiUKV>(lds, t, lo, 8, 8, ckvs, (const bf16_t*)(ws + O_WCUKV), MALL, kkv, E, head, dep, need, nullptr, x, wave_s); lo += 64; ++k; }
                } else {
                    constexpr int nkv = l == 3 ? 16 : 4; constexpr int ntn = (1024 + 2 * nkv * 64) / 256;
                    const bf16_t* Bt = (const bf16_t*)(ws + (l == 0 ? O_WAQKV : l == 1 ? O_WBQKV : O_WDQKV));
                    float* ok = a.out + (l == 0 ? OUT_AK : l == 1 ? OUT_BK : OUT_DK); float* ov = a.out + (l == 0 ? OUT_AV : l == 1 ? OUT_BV : OUT_DV);
                    const float* qg = l == 0 ? a.in[22] : l == 1 ? a.in[27] : a.in[39]; const float* kg = l == 0 ? a.in[23] : l == 1 ? a.in[28] : a.in[40];
                    EpiQKV E{stats, bl, nkv, l < 2 ? 1 : 0, qg, kg, cshd, qb, kb, vb, ok, ov};
                    run_stage<EpiQKV>(lds, t, lo, ntn, 6, xs, Bt, M, D, E, head, dep, need, nullptr, x, wave_s); lo += ntn * 6; ++k;
                }
            }
#undef STAGE_ADV
        }
        return did;
}
template <int PH> DI void run_all(const Args& a, LAS unsigned char* lds, int wave_s, unsigned& nbar) {
    if constexpr (PH < 12) {
        if (a.ph_lo <= PH && PH < a.ph_hi) {
            const bool did = run_phase<PH>(a, lds, wave_s);
#if 0
            { constexpr bool rep = (PH >= 4 && PH != 8 && (PH & 1) == 0 && (REP_MASK & 4)) || (PH == 2 && (REP_MASK & 32)) || (PH == 1 && (REP_MASK & 64));
              if constexpr (rep) { __syncthreads(); (void)run_phase<PH>(a, lds, wave_s); } }
#endif
            if (did && PH + 1 < a.ph_hi) { const int tid = wave_s * 64 + (int)__builtin_amdgcn_mbcnt_hi(~0u, __builtin_amdgcn_mbcnt_lo(~0u, 0u)); grid_bar((unsigned*)(a.ws + O_CTL), (volatile LAS unsigned*)(lds + RING_BYTES + 320), tid); }
        }
        run_all<PH + 1>(a, lds, wave_s, nbar);
    }
}
__global__ void __launch_bounds__(NTHR, 2) mega(Args a) {
    extern __shared__ __attribute__((aligned(16))) unsigned char lds_raw[];
    LAS unsigned char* lds = (LAS unsigned char*)lds_raw;
    if (a.ph_hi < 0) { cg::grid_group grid = cg::this_grid(); grid.sync(); }
    const int wave_s = __builtin_amdgcn_readfirstlane(threadIdx.x >> 6);
    unsigned nbar = 0;
    if (threadIdx.x < 64) ((LAS unsigned*)(lds + RING_BYTES))[threadIdx.x + 64] = 0u;
    __syncthreads();
    if (threadIdx.x == 0) (void)xb_add((unsigned*)(a.ws + O_CTL) + XB_XCNT(xb_xcc_id()), 1u);
    run_all<0>(a, lds, wave_s, nbar);
}

constexpr int N_PHASES = 12;
extern "C" void kernel_launch(void* const* d_in, const int* in_sizes, int n_in, void* d_out, int out_size, void* d_ws, size_t ws_size, hipStream_t stream) {
    static int grid = 0;
    if (grid == 0) {
        if (n_in != 43 || ws_size < WS_NEED || out_size != 26345472) { fprintf(stderr, "kernel_launch: unexpected problem shape (n_in %d, out %d, ws %zu need %zu)\n", n_in, out_size, ws_size, (size_t)WS_NEED); grid = -1; return; }
        int dev = 0, cus = 0, per_cu = 0;
        hipGetDevice(&dev); hipDeviceGetAttribute(&cus, hipDeviceAttributeMultiprocessorCount, dev);
        if (hipFuncSetAttribute((const void*)mega, hipFuncAttributeMaxDynamicSharedMemorySize, LDS_BYTES) != hipSuccess) { fprintf(stderr, "kernel_launch: hipFuncSetAttribute failed\n"); grid = -1; return; }
        if (hipOccupancyMaxActiveBlocksPerMultiprocessor(&per_cu, (const void*)mega, NTHR, LDS_BYTES) != hipSuccess || per_cu < 1) { fprintf(stderr, "kernel_launch: occupancy query says %d\n", per_cu); per_cu = 1; }
        (void)hipGetLastError();
        grid = cus * 1;
        if (grid <= 0) grid = 256;
    }
    if (grid < 0) return;
    if (hipMemsetAsync((char*)d_ws + O_CTL, 0, CTL_BYTES, stream) != hipSuccess) { fprintf(stderr, "kernel_launch: memset failed\n"); return; }
    Args a{};
    for (int i = 0; i < 43; ++i) a.in[i] = (const float*)d_in[i];
    a.out = (float*)d_out; a.ws = (unsigned char*)d_ws; a.ph_lo = 0; a.ph_hi = N_PHASES;
    void* args[] = {&a};
    hipError_t e = hipLaunchCooperativeKernel((const void*)mega, dim3(grid), dim3(NTHR), args, LDS_BYTES, stream);
    if (e != hipSuccess) fprintf(stderr, "kernel_launch: cooperative launch failed: %s (grid %d)\n", hipGetErrorString(e), grid);
}
```
